# Optimizing an MI355X kernel written in HIP

```python
import jax, jax.numpy as jnp
from jax import lax
import numpy as np

D_MODEL = 2048
BATCH = 1
SEQ = 16384
DEPTH = 2

HEAD_DIM = 128
N_MEM = 256
MEM_HEADS = 4
DIL_GROUPS = ((128, 1), (512, 4), (2048, 16))
HEADS_PER_GROUP = 4
DIL_HEADS = len(DIL_GROUPS) * HEADS_PER_GROUP
SB_HEADS = 12
BLOCK = 128
D_FF = 5632
CONV_WIDTH = 3
ROPE_THETA = 10000.0
EPS = 1e-6
NEG_INF = -1e30
N_A = DEPTH // 2
N_B = DEPTH - N_A

DIL_W = DIL_HEADS * HEAD_DIM
MEM_W = MEM_HEADS * HEAD_DIM
SB_W = SB_HEADS * HEAD_DIM
A_IN = 3 * DIL_W + MEM_W
B_IN = SB_W + MEM_W
A_OUT = HEADS_PER_GROUP * HEAD_DIM + MEM_W
B_OUT = SB_W + MEM_W

kernel_name = "yoco_dilated_stickbreaking_hybrid"


def _rmsnorm(x, g):
    xf = x.astype(jnp.float32)
    y = xf * lax.rsqrt(jnp.mean(xf * xf, axis=-1, keepdims=True) + EPS)
    return (y * g.astype(jnp.float32)).astype(x.dtype)


def _rope_tables(S):
    pos = jnp.arange(S, dtype=jnp.float32)
    inv = ROPE_THETA ** (-jnp.arange(0, HEAD_DIM, 2, dtype=jnp.float32) / HEAD_DIM)
    ang = pos[:, None] * inv[None, :]
    return jnp.cos(ang), jnp.sin(ang)


def _rope(x, cos, sin):
    half = x.shape[-1] // 2
    xf = x.astype(jnp.float32)
    x1, x2 = xf[..., :half], xf[..., half:]
    c, s = cos[None, :, None, :], sin[None, :, None, :]
    return jnp.concatenate([x1 * c - x2 * s, x2 * c + x1 * s], axis=-1).astype(x.dtype)


def _dilated_group(q, k, v, window, dilation):
    B, S, H, E = q.shape
    L = S // dilation
    nb = -(-L // BLOCK)
    Lp = nb * BLOCK
    span = window // dilation

    def to_blocks(t):
        t = t.reshape(B, L, dilation, H, E).transpose(0, 2, 3, 1, 4)
        t = jnp.pad(t, ((0, 0), (0, 0), (0, 0), (0, Lp - L), (0, 0)))
        return t.reshape(B, dilation, H, nb, BLOCK, E)

    def with_prev(t):
        prev = jnp.pad(t[:, :, :, :-1], ((0, 0), (0, 0), (0, 0), (1, 0), (0, 0), (0, 0)))
        return jnp.concatenate([prev, t], axis=4)

    qb, kb, vb = to_blocks(q), to_blocks(k), to_blocks(v)
    kk, vv = with_prev(kb), with_prev(vb)
    s = jnp.einsum('bdhnqe,bdhnke->bdhnqk', qb, kk,
                   preferred_element_type=jnp.float32) * (E ** -0.5)
    blk = jnp.arange(nb)[:, None, None]
    n_idx = blk * BLOCK + jnp.arange(BLOCK)[None, :, None]
    m_idx = (blk - 1) * BLOCK + jnp.arange(2 * BLOCK)[None, None, :]
    rel = n_idx - m_idx
    valid = (rel >= 0) & (rel <= span) & (m_idx >= 0)
    s = jnp.where(valid, s, NEG_INF)
    lse = jax.nn.logsumexp(s, axis=-1)
    p = jnp.exp(s - lse[..., None])
    o = jnp.einsum('bdhnqk,bdhnke->bdhnqe', p.astype(v.dtype), vv,
                   preferred_element_type=jnp.float32)
    o = o.reshape(B, dilation, H, Lp, E)[:, :, :, :L].transpose(0, 3, 1, 2, 4).reshape(B, S, H, E)
    lse = lse.reshape(B, dilation, H, Lp)[..., :L].transpose(0, 3, 1, 2).reshape(B, S, H)
    return o, lse


def _stick_breaking(q, k, v):
    B, S, H, E = q.shape
    nb = S // BLOCK
    scale = E ** -0.5
    qb = q.reshape(B, nb, BLOCK, H, E).transpose(1, 0, 3, 2, 4)
    kt = k.transpose(0, 2, 1, 3)
    vt = v.transpose(0, 2, 1, 3)
    key_pos = jnp.arange(S)

    def block(args):
        qblk, i = args
        z = jnp.einsum('bhqe,bhke->bhqk', qblk, kt,
                       preferred_element_type=jnp.float32) * scale
        q_pos = i * BLOCK + jnp.arange(BLOCK)
        causal = key_pos[None, :] < q_pos[:, None]
        log_keep = jnp.where(causal, jax.nn.log_sigmoid(-z), 0.0)
        later = lax.cumsum(log_keep, axis=3, reverse=True) - log_keep
        a = jnp.where(causal, jnp.exp(jax.nn.log_sigmoid(z) + later), 0.0)
        return jnp.einsum('bhqk,bhke->bhqe', a.astype(vt.dtype), vt,
                          preferred_element_type=jnp.float32).astype(q.dtype)

    o = lax.map(block, (qb, jnp.arange(nb)))
    return o.transpose(1, 0, 3, 2, 4).reshape(B, S, H, E)


def _memory_attention(qm, mem, g_mem, w_mem_kv):
    B, S, _ = qm.shape
    mkv = _rmsnorm(mem, g_mem) @ w_mem_kv
    mk, mv = jnp.split(mkv, 2, axis=-1)
    M = mem.shape[1]
    q = qm.reshape(B, S, MEM_HEADS, HEAD_DIM)
    mk = mk.reshape(B, M, MEM_HEADS, HEAD_DIM)
    mv = mv.reshape(B, M, MEM_HEADS, HEAD_DIM)
    s = jnp.einsum('bshe,bmhe->bhsm', q, mk, preferred_element_type=jnp.float32) * (HEAD_DIM ** -0.5)
    p = jax.nn.softmax(s, axis=-1)
    o = jnp.einsum('bhsm,bmhe->bshe', p.astype(mv.dtype), mv, preferred_element_type=jnp.float32)
    return o.astype(qm.dtype).reshape(B, S, MEM_W)


def _conv_ffn(h, w_up, w_conv, b_conv, w_down):
    S = h.shape[1]
    u = h @ w_up
    gate, val = jnp.split(u, 2, axis=-1)
    gp = jnp.pad(gate, ((0, 0), (CONV_WIDTH - 1, 0), (0, 0)))
    acc = b_conv + gp[:, CONV_WIDTH - 1:CONV_WIDTH - 1 + S] * w_conv[CONV_WIDTH - 1]
    for j in range(CONV_WIDTH - 1):
        acc = acc + gp[:, j:j + S] * w_conv[j]
    return (jax.nn.silu(acc) * val) @ w_down


def _finish_layer(x, heads, w_o, norms, w_up, w_conv, b_conv, w_down):
    x = x + _rmsnorm(heads @ w_o, norms[1])
    f = _conv_ffn(_rmsnorm(x, norms[2]), w_up, w_conv, b_conv, w_down)
    return x + _rmsnorm(f, norms[3])


def setup_inputs(seed: int = 0) -> dict:
    key = jax.random.key(seed)
    ks = jax.random.split(key, 16)
    D = D_MODEL

    def w(k, shape, fan_in):
        return jax.random.normal(k, shape, jnp.float32) * (fan_in ** -0.5)

    return {
        'x': jax.random.normal(ks[0], (BATCH, SEQ, D), jnp.float32),
        'mem': jax.random.normal(ks[1], (BATCH, N_MEM, D), jnp.float32),
        'norms': 1.0 + 0.05 * jax.random.normal(ks[2], (DEPTH, 5, D), jnp.float32),
        'w_in_a': w(ks[3], (N_A, D, A_IN), D),
        'w_o_a': w(ks[4], (N_A, A_OUT, D), A_OUT),
        'g_kv': 1.0 + 0.05 * jax.random.normal(ks[5], (D,), jnp.float32),
        'w_kv': w(ks[6], (D, 2 * SB_W), D),
        'w_in_b': w(ks[7], (N_B, D, B_IN), D),
        'w_o_b': w(ks[8], (N_B, B_OUT, D), B_OUT),
        'w_mem_kv': w(ks[9], (DEPTH, D, 2 * MEM_W), D),
        'w_up': w(ks[10], (DEPTH, D, 2 * D_FF), D),
        'w_conv': w(ks[11], (DEPTH, CONV_WIDTH, D_FF), CONV_WIDTH),
        'b_conv': 0.01 * jax.random.normal(ks[12], (DEPTH, D_FF), jnp.float32),
        'w_down': w(ks[13], (DEPTH, D_FF, D), D_FF),
    }


def reference(x, mem, norms, w_in_a, w_o_a, g_kv, w_kv, w_in_b, w_o_b,
              w_mem_kv, w_up, w_conv, b_conv, w_down):
    B, S, _ = x.shape
    cos, sin = _rope_tables(S)
    k_sh = v_sh = None
    for layer in range(DEPTH):
        nrm = norms[layer]
        if layer < N_A:
            h = _rmsnorm(x, nrm[0])
            proj = h @ w_in_a[layer]
            q, k, v, qm = jnp.split(proj, [DIL_W, 2 * DIL_W, 3 * DIL_W], axis=-1)
            q = _rope(q.reshape(B, S, DIL_HEADS, HEAD_DIM), cos, sin)
            k = _rope(k.reshape(B, S, DIL_HEADS, HEAD_DIM), cos, sin)
            v = v.reshape(B, S, DIL_HEADS, HEAD_DIM)
            outs, lses = [], []
            for gi, (window, dilation) in enumerate(DIL_GROUPS):
                sl = slice(gi * HEADS_PER_GROUP, (gi + 1) * HEADS_PER_GROUP)
                o_g, l_g = _dilated_group(q[:, :, sl], k[:, :, sl], v[:, :, sl], window, dilation)
                outs.append(o_g)
                lses.append(l_g)
            wts = jax.nn.softmax(jnp.stack(lses, axis=0), axis=0)
            o_dil = jnp.sum(wts[..., None] * jnp.stack(outs, axis=0), axis=0).astype(x.dtype)
            o_mem = _memory_attention(qm, mem, nrm[4], w_mem_kv[layer])
            heads = jnp.concatenate([o_dil.reshape(B, S, -1), o_mem], axis=-1)
            x = _finish_layer(x, heads, w_o_a[layer], nrm, w_up[layer], w_conv[layer],
                              b_conv[layer], w_down[layer])
        else:
            if layer == N_A:
                kv = _rmsnorm(x, g_kv) @ w_kv
                k_sh, v_sh = jnp.split(kv, 2, axis=-1)
                k_sh = k_sh.reshape(B, S, SB_HEADS, HEAD_DIM)
                v_sh = v_sh.reshape(B, S, SB_HEADS, HEAD_DIM)
            lb = layer - N_A
            h = _rmsnorm(x, nrm[0])
            proj = h @ w_in_b[lb]
            q, qm = jnp.split(proj, [SB_W], axis=-1)
            o_sb = _stick_breaking(q.reshape(B, S, SB_HEADS, HEAD_DIM), k_sh, v_sh)
            o_mem = _memory_attention(qm, mem, nrm[4], w_mem_kv[layer])
            heads = jnp.concatenate([o_sb.reshape(B, S, -1), o_mem], axis=-1)
            x = _finish_layer(x, heads, w_o_b[lb], nrm, w_up[layer], w_conv[layer],
                              b_conv[layer], w_down[layer])
    return x
```

```cpp
#include <hip/hip_runtime.h>
#include <hip/hip_cooperative_groups.h>
#include <cstdio>
__device__ __forceinline__ int opaque_tid(int wave_s) { unsigned m = ~0u; asm volatile("" : "+s"(m)); int w = wave_s; asm volatile("" : "+s"(w));
    int t = w * 64 + (int)__builtin_amdgcn_mbcnt_hi(m, __builtin_amdgcn_mbcnt_lo(m, 0u)); asm volatile("" : "+v"(t)); return t; }
namespace pg8 {
#define PG8_LAS __attribute__((address_space(3)))
typedef unsigned short bf16_t;
typedef short bf16x8 __attribute__((ext_vector_type(8)));
typedef float f32x4 __attribute__((ext_vector_type(4)));
typedef unsigned u32x4 __attribute__((ext_vector_type(4)));
constexpr int BM = 256, BK = 64, HALF = 128, HTB = HALF * BK * 2  , STAGE_BYTES = 8 * HTB, NXCD = 8, WGM = 8;

__host__ __device__ __forceinline__ int lds_byte(int r, int c) { const int st = (r >> 4) * 2 + (c >> 5), rr = r & 15, cc = c & 31, ob = rr * 64 + cc * 2; return st * 1024 + (ob ^ (((ob >> 9) & 1) << 5)); }
__host__ __device__ __forceinline__ void stage_rc(int b, int& R, int& C) { const int st = b / 1024, sb = b % 1024, swz = sb ^ (((sb >> 9) & 1) << 5); R = (st >> 1) * 16 + swz / 64; C = (st & 1) * 32 + (swz % 64) / 2; }
__host__ __device__ __forceinline__ int perm32(int rho) { const int n = rho >> 4, i = rho & 15; return 8 * (i >> 2) + 4 * n + (i & 3); }


struct Unit { int pm, pn; };
struct Gemm { const bf16_t* A; const bf16_t* Bt; int M, N, K; };
struct StaticOrder {
    int nM, nN, nwg, G, c;
    __host__ __device__ void init(int M, int N, int G_, int c_) { nM = M / BM; nN = N / BM; nwg = nM * nN; G = G_; c = c_; }
    __host__ __device__ bool next(int i, Unit& u) const {
        const long L = (long)i * G + c; if (L >= nwg) return false;
        int wgid = (int)L; { const int q = nwg / NXCD, r = nwg % NXCD, xcd = wgid % NXCD, off = wgid / NXCD; wgid = (xcd < r ? xcd * (q + 1) : r * (q + 1) + (xcd - r) * q) + off; }
        const int nig = WGM * nN, gid = wgid / nig, fm = gid * WGM, gsz = (nM - fm) < WGM ? (nM - fm) : WGM;
        u.pm = fm + ((wgid % nig) % gsz); u.pn = (wgid % nig) / gsz; return true;
    }
    __device__ __forceinline__ void a_ready(const Unit&) const {}
    __device__ __forceinline__ void done(const Unit&) const {}
};

template <class Epi, class Sched, bool STAMP = false>
__device__ __forceinline__ void gemm_phase(PG8_LAS unsigned char* lds, const Gemm g, const Sched& S, const Epi& E, unsigned long long* stamps, int wave_s) {
    const int tid = opaque_tid(wave_s), wid = __builtin_amdgcn_readfirstlane(tid >> 6), lane = tid & 63, wr = wid >> 2, wc = wid & 3, fr = lane & 15, fq = lane >> 4;
    const int K = g.K, nt = K / BK;
    int ts_lo = 0, ts_hi = 0, nts = 0; const unsigned long long rt_entry = STAMP ? (unsigned long long)wall_clock64() : 0ull;
#define PG8_STAMP() do { if (STAMP && wid == 0 && nts < 64) { const unsigned long long _c = (unsigned long long)clock64(); \
        ts_lo = (lane == nts) ? (int)(unsigned)_c : ts_lo; ts_hi = (lane == nts) ? (int)(unsigned)(_c >> 32) : ts_hi; ++nts; } } while (0)
    PG8_STAMP();
    unsigned voffA[2], voffB[2];
#pragma unroll
    for (int i = 0; i < 2; ++i) { int R, C; stage_rc(tid * 16 + i * 8192, R, C); const int Rb = Epi::PERM ? ((R & ~31) + perm32(R & 31)) : R;
        voffA[i] = (unsigned)(R * K + C) * 2u; voffB[i] = (unsigned)(Rb * K + C) * 2u; }
    const size_t kstep = (size_t)(BK * 2);
    const size_t hstep = (size_t)HALF * K * 2;
    const size_t tstep = 2 * hstep;
    const unsigned ldsw = (unsigned)wid * 1024u;
    const int aoff = lds_byte(wr * 64 + fr, fq * 8), boff = lds_byte(wc * 32 + fr, fq * 8);
#define PG8_SA(b, h) (((b) * 2 + (h)) * HTB)
#define PG8_SB(b, h) ((4 + (b) * 2 + (h)) * HTB)
#define PG8_STAGE(bufoff, gbase, voff) do { _Pragma("unroll") for (int _i = 0; _i < 2; ++_i) \
        __builtin_amdgcn_global_load_lds((const unsigned*)((const char*)(gbase) + (voff)[_i]), (PG8_LAS unsigned*)(lds + (bufoff) + ldsw + _i * 8192), 16, 0, 0); } while (0)
#define PG8_LDA(dst, b, h) do { _Pragma("unroll") for (int m = 0; m < 4; ++m) _Pragma("unroll") for (int k = 0; k < 2; ++k) dst[m][k] = *(const PG8_LAS bf16x8*)(lds + PG8_SA(b, h) + aoff + m * 2048 + k * 1024); } while (0)
#define PG8_LDB(dst, b, h) do { _Pragma("unroll") for (int n = 0; n < 2; ++n) _Pragma("unroll") for (int k = 0; k < 2; ++k) dst[n][k] = *(const PG8_LAS bf16x8*)(lds + PG8_SB(b, h) + boff + n * 2048 + k * 1024); } while (0)
#define PG8_MMA(ai, bj, At, Bt) do { __builtin_amdgcn_s_setprio(1); _Pragma("unroll") for (int m = 0; m < 4; ++m) _Pragma("unroll") for (int n = 0; n < 2; ++n) _Pragma("unroll") for (int k = 0; k < 2; ++k) \
        acc[ai][bj][m][n] = __builtin_amdgcn_mfma_f32_16x16x32_bf16(Bt[n][k], At[m][k], acc[ai][bj][m][n], 0, 0, 0); __builtin_amdgcn_s_setprio(0); } while (0)
#define PG8_WAIT_V(n) asm volatile("s_waitcnt vmcnt(" #n ")" ::: "memory")
#define PG8_WAIT_L(n) asm volatile("s_waitcnt lgkmcnt(" #n ")" ::: "memory")
#define PG8_BAR __builtin_amdgcn_s_barrier()
#define PG8_SCHED __builtin_amdgcn_sched_barrier(0)
    Unit cur, nxt; int ui = 0;
    if (!S.next(0, cur)) return;
    f32x4 acc[2][2][4][2];
#pragma unroll
    for (int a = 0; a < 2; ++a)
#pragma unroll
        for (int b = 0; b < 2; ++b)
#pragma unroll
            for (int m = 0; m < 4; ++m)
#pragma unroll
                for (int n = 0; n < 2; ++n) acc[a][b][m][n] = (f32x4){0.f, 0.f, 0.f, 0.f};
    bf16x8 At[4][2], B0[2][2], B1[2][2];
    const char* cA = (const char*)g.A + (size_t)cur.pm * tstep; const char* cB = (const char*)g.Bt + (size_t)cur.pn * tstep;
    S.a_ready(cur);
    PG8_STAGE(PG8_SB(0, 0), cB, voffB); PG8_STAGE(PG8_SA(0, 0), cA, voffA); PG8_STAGE(PG8_SB(0, 1), cB + hstep, voffB); PG8_STAGE(PG8_SA(0, 1), cA + hstep, voffA);
    if (wr == 1) PG8_BAR;
    PG8_WAIT_V(4); PG8_BAR;
    PG8_STAGE(PG8_SB(1, 0), cB + kstep, voffB); PG8_STAGE(PG8_SA(1, 0), cA + kstep, voffA); PG8_STAGE(PG8_SB(1, 1), cB + hstep + kstep, voffB);
    PG8_WAIT_V(6); PG8_BAR;
    PG8_STAMP();
    for (;;) {
        const bool has_next = S.next(ui + 1, nxt);
        const char* nA = has_next ? (const char*)g.A + (size_t)nxt.pm * tstep : cA; const char* nB = has_next ? (const char*)g.Bt + (size_t)nxt.pn * tstep : cB;
        for (int t = 0; t < nt; t += 2) {
            const bool last = (t == nt - 2);
            const char* a1 = cA + (size_t)(t + 1) * kstep;
            const char* a2 = last ? nA : cA + (size_t)(t + 2) * kstep; const char* b2 = last ? nB : cB + (size_t)(t + 2) * kstep;
            const char* a3 = a2 + kstep; const char* b3 = b2 + kstep;
            if (last && has_next) S.a_ready(nxt);
            PG8_LDB(B0, 0, 0); PG8_SCHED; PG8_LDA(At, 0, 0); PG8_STAGE(PG8_SA(1, 1), a1 + hstep, voffA);
            PG8_WAIT_L(8); PG8_BAR; PG8_WAIT_L(0); PG8_MMA(0, 0, At, B0); PG8_BAR; PG8_SCHED;
            PG8_LDB(B1, 0, 1); PG8_STAGE(PG8_SB(0, 0), b2, voffB);
            PG8_BAR; PG8_WAIT_L(0); PG8_MMA(0, 1, At, B1); PG8_BAR;
            PG8_LDA(At, 0, 1); PG8_STAGE(PG8_SA(0, 0), a2, voffA);
            PG8_BAR; PG8_WAIT_L(0); PG8_MMA(1, 0, At, B0); PG8_BAR; PG8_SCHED;
            PG8_STAGE(PG8_SB(0, 1), b2 + hstep, voffB);
            PG8_WAIT_V(6); PG8_BAR; PG8_MMA(1, 1, At, B1); PG8_BAR;
            PG8_LDB(B0, 1, 0); PG8_SCHED; PG8_LDA(At, 1, 0); PG8_STAGE(PG8_SA(0, 1), a2 + hstep, voffA);
            PG8_WAIT_L(8); PG8_BAR; PG8_WAIT_L(0); PG8_MMA(0, 0, At, B0); PG8_BAR; PG8_SCHED;
            PG8_LDB(B1, 1, 1); PG8_STAGE(PG8_SB(1, 0), b3, voffB);
            PG8_BAR; PG8_WAIT_L(0); PG8_MMA(0, 1, At, B1); PG8_BAR;
            PG8_LDA(At, 1, 1); PG8_STAGE(PG8_SA(1, 0), a3, voffA);
            PG8_BAR; PG8_WAIT_L(0); PG8_MMA(1, 0, At, B0); PG8_BAR; PG8_SCHED;
            PG8_STAGE(PG8_SB(1, 1), b3 + hstep, voffB);
            PG8_WAIT_V(6); PG8_BAR; PG8_MMA(1, 1, At, B1); PG8_BAR;
        }
        PG8_STAMP();
        if constexpr (!Epi::AFTER_DRAIN) { E(acc, cur, wr, wc, fr, fq); S.done(cur); }
        PG8_STAMP();
        if (!has_next) break;
#pragma unroll
        for (int a = 0; a < 2; ++a)
#pragma unroll
            for (int b = 0; b < 2; ++b)
#pragma unroll
                for (int m = 0; m < 4; ++m)
#pragma unroll
                    for (int n = 0; n < 2; ++n) acc[a][b][m][n] = (f32x4){0.f, 0.f, 0.f, 0.f};
        cur = nxt; cA = nA; cB = nB; ++ui;
    }
    PG8_WAIT_V(0);
    if (wr == 0) PG8_BAR;
    PG8_BAR;
    if constexpr (Epi::AFTER_DRAIN) { E.fused(acc, cur, wr, wc, fr, fq, lds, wid, lane); S.done(cur); }
    PG8_STAMP();
    if (STAMP && wid == 0) { stamps[lane] = lane < nts ? (((unsigned long long)(unsigned)ts_hi << 32) | (unsigned)ts_lo) : 0ull;
        if (lane == 62) stamps[62] = rt_entry; if (lane == 63) stamps[63] = (unsigned long long)wall_clock64(); }
#undef PG8_STAMP
#undef PG8_SA
#undef PG8_SB
#undef PG8_STAGE
#undef PG8_LDA
#undef PG8_LDB
#undef PG8_MMA
#undef PG8_WAIT_V
#undef PG8_WAIT_L
#undef PG8_BAR
#undef PG8_SCHED
}

typedef __bf16 nbf2 __attribute__((ext_vector_type(2)));
typedef float f32x2n __attribute__((ext_vector_type(2)));
typedef unsigned u32x2 __attribute__((ext_vector_type(2)));
__device__ __forceinline__ unsigned pk2(float lo, float hi) { return __builtin_bit_cast(unsigned, __builtin_convertvector((f32x2n){lo, hi}, nbf2)); }
__device__ __forceinline__ u32x4 pk8(const f32x4& a, const f32x4& b) { u32x4 w; w.x = pk2(a[0], a[1]); w.y = pk2(a[2], a[3]); w.z = pk2(b[0], b[1]); w.w = pk2(b[2], b[3]); return w; }

struct EpiProj {
    static constexpr bool PERM = true, AFTER_DRAIN = false;
    bf16_t* O; int ldc; int rope_units; const float* cs; const float* sn;
    __device__ __forceinline__ void operator()(const f32x4 (&acc)[2][2][4][2], const Unit& u, int wr, int wc, int fr, int fq) const {
        const int row0 = u.pm * BM + wr * 64 + fr;
        if (u.pn < rope_units) {
            const int fi = 32 * (wc & 1) + 8 * fq;
            const int colb = u.pn * BM + 128 * (wc >> 1) + fi;
#pragma unroll
            for (int ai = 0; ai < 2; ++ai)
#pragma unroll
                for (int m = 0; m < 4; ++m) {
                    const int row = row0 + ai * HALF + m * 16;
                    const f32x4 c0 = *(const f32x4*)(cs + (size_t)row * 64 + fi), c1 = *(const f32x4*)(cs + (size_t)row * 64 + fi + 4);
                    const f32x4 s0 = *(const f32x4*)(sn + (size_t)row * 64 + fi), s1 = *(const f32x4*)(sn + (size_t)row * 64 + fi + 4);
                    const f32x4 x1a = acc[ai][0][m][0], x1b = acc[ai][0][m][1], x2a = acc[ai][1][m][0], x2b = acc[ai][1][m][1];
                    const f32x4 la = x1a * c0 - x2a * s0, lb = x1b * c1 - x2b * s1, ha = x2a * c0 + x1a * s0, hb = x2b * c1 + x1b * s1;
                    bf16_t* rowp = O + (size_t)row * ldc + colb;
                    *(u32x4*)(rowp) = pk8(la, lb); *(u32x4*)(rowp + 64) = pk8(ha, hb);
                }
        } else {
            const int col0 = u.pn * BM + wc * 32 + 8 * fq;
#pragma unroll
            for (int ai = 0; ai < 2; ++ai)
#pragma unroll
                for (int m = 0; m < 4; ++m) { bf16_t* rowp = O + (size_t)(row0 + ai * HALF + m * 16) * ldc + col0;
#pragma unroll
                    for (int bj = 0; bj < 2; ++bj) *(u32x4*)(rowp + bj * HALF) = pk8(acc[ai][bj][m][0], acc[ai][bj][m][1]); }
        }
    }
};

struct EpiY {
    static constexpr bool PERM = false, AFTER_DRAIN = false;
    float* C; int ldc; float* sumsq;
    __device__ __forceinline__ void operator()(const f32x4 (&acc)[2][2][4][2], const Unit& u, int wr, int wc, int fr, int fq) const {
        const int row0 = u.pm * BM + wr * 64 + fr, col0 = u.pn * BM + wc * 32 + 4 * fq;
#pragma unroll
        for (int ai = 0; ai < 2; ++ai)
#pragma unroll
            for (int m = 0; m < 4; ++m) { const int row = row0 + ai * HALF + m * 16; float* rowp = C + (size_t)row * ldc + col0; float ss = 0.f;
#pragma unroll
                for (int bj = 0; bj < 2; ++bj)
#pragma unroll
                    for (int n = 0; n < 2; ++n) { const f32x4 v = acc[ai][bj][m][n]; *(f32x4*)(rowp + bj * HALF + n * 16) = v; ss += (v[0] * v[0] + v[1] * v[1]) + (v[2] * v[2] + v[3] * v[3]); }
                ss += __shfl_xor(ss, 16); ss += __shfl_xor(ss, 32);
                if (fq == 0) unsafeAtomicAdd(sumsq + row, ss); }
    }
};

struct EpiUp {
    static constexpr bool PERM = true, AFTER_DRAIN = false;
    bf16_t* act; const float* wconv; const float* bconv; float* first; float* last;
    __device__ __forceinline__ void operator()(const f32x4 (&acc)[2][2][4][2], const Unit& u, int wr, int wc, int fr, int fq) const {
        constexpr int DFF = 5632;
        const int lane = (fq << 4) | fr;
        const int l1 = (lane & 48) | ((fr + 15) & 15), l2 = (lane & 48) | ((fr + 14) & 15);
        const int c0 = u.pn * HALF + wc * 32 + 8 * fq;
#pragma unroll
        for (int n = 0; n < 2; ++n) {
            const f32x4 w0 = *(const f32x4*)(wconv + c0 + 4 * n), w1 = *(const f32x4*)(wconv + DFF + c0 + 4 * n), w2 = *(const f32x4*)(wconv + 2 * DFF + c0 + 4 * n), bc = *(const f32x4*)(bconv + c0 + 4 * n);
#pragma unroll
            for (int ai = 0; ai < 2; ++ai) {
                const int seg = u.pm * 4 + ai * 2 + wr;
                f32x4 o[4];
#pragma unroll
                for (int j = 0; j < 4; ++j) {
                    float g[4], p1[4], p2[4];
#pragma unroll
                    for (int m = 0; m < 4; ++m) { g[m] = acc[ai][0][m][n][j]; p1[m] = __shfl(g[m], l1); p2[m] = __shfl(g[m], l2); }
#pragma unroll
                    for (int m = 0; m < 4; ++m) {
                        const float pv1 = (fr >= 1) ? p1[m] : (m > 0 ? p1[m > 0 ? m - 1 : 0] : 0.f);
                        const float pv2 = (fr >= 2) ? p2[m] : (m > 0 ? p2[m > 0 ? m - 1 : 0] : 0.f);
                        const float a = bc[j] + w2[j] * g[m] + w1[j] * pv1 + w0[j] * pv2;
                        const float sg = __builtin_amdgcn_rcpf(1.0f + __builtin_amdgcn_exp2f(-1.44269504089f * a));
                        o[m][j] = a * sg * acc[ai][1][m][n][j];
                    }
                }
#pragma unroll
                for (int m = 0; m < 4; ++m) {
                    const int row = seg * 64 + m * 16 + fr;
                    if (m > 0 || fr >= 2) { u32x2 w; w.x = pk2(o[m][0], o[m][1]); w.y = pk2(o[m][2], o[m][3]); *(u32x2*)(act + (size_t)row * DFF + c0 + 4 * n) = w; }
                }
                if (fr < 2) {
                    float* fp = first + ((size_t)(seg * 2 + fr) * 2) * DFF + c0 + 4 * n;
                    *(f32x4*)(fp) = acc[ai][0][0][n]; *(f32x4*)(fp + DFF) = acc[ai][1][0][n];
                }
                if (fr >= 14) {
                    float* lp = last + (size_t)(seg * 2 + (fr - 14)) * DFF + c0 + 4 * n;
                    *(f32x4*)(lp) = acc[ai][0][3][n];
                }
            }
        }
    }
};
}

using pg8::bf16_t; using pg8::bf16x8; using pg8::f32x4; using pg8::u32x4;
#define LAS PG8_LAS
typedef float f32x16 __attribute__((ext_vector_type(16)));
typedef short s16x4 __attribute__((ext_vector_type(4)));
using pg8::u32x2;

constexpr int S_ = 16384, D_ = 2048, DFF_ = 5632, NMEM_ = 256;
constexpr float EPS_ = 1e-6f;
constexpr int LDS_BYTES = pg8::STAGE_BYTES + 1024;
constexpr int NPHASE = 19;

struct Params {
    const float *x, *mem, *norms, *w_in_a, *w_o_a, *g_kv, *w_kv, *w_in_b, *w_o_b, *w_mem_kv, *w_up, *w_conv, *b_conv, *w_down;
    float* out;
    bf16_t *BtA, *BtM, *BtOA, *BtUp0, *BtDn0, *BtB, *BtOB, *BtUp1, *BtDn1;
    float *cs, *sn;
    bf16_t *h, *hm, *mkv, *big, *heads;
    float *y, *lse, *sumsq;
    long long coop;
};

enum { K_PREP = 0, K_GPROJ, K_ATTN, K_MERGE, K_GY, K_ROW, K_GUP, K_FIX };
constexpr unsigned long long pack_tab(const int* a, int n, int bits) { unsigned long long v = 0; for (int i = 0; i < n; ++i) v |= (unsigned long long)a[i] << (bits * i); return v; }
constexpr int PH_KINDS[NPHASE] = {K_PREP, K_GPROJ, K_GPROJ, K_ATTN, K_MERGE, K_GY, K_ROW, K_GUP, K_FIX, K_GY, K_ROW, K_GPROJ, K_ATTN, K_GY, K_ROW, K_GUP, K_FIX, K_GY, K_ROW};
constexpr int PH_VARS[NPHASE]  = {0,      0,       1,       0,      0,       0,    0,     0,     0,     1,    1,     2,       1,      2,    2,     1,     1,     3,    3};
constexpr int PH_SYNCS[NPHASE] = {1,      0,       1,       1,      1,       1,    1,     1,     1,     1,    1,     1,       1,      1,    1,     1,     1,     1,    0};
constexpr unsigned long long PK_KINDS = pack_tab(PH_KINDS, NPHASE, 3), PK_VARS = pack_tab(PH_VARS, NPHASE, 2), PK_SYNCS = pack_tab(PH_SYNCS, NPHASE, 1);
__host__ __device__ inline void phase_info(int ph, int& kind, int& var, int& sync_after) {
    kind = (int)((PK_KINDS >> (3 * ph)) & 7ull); var = (int)((PK_VARS >> (2 * ph)) & 3ull); sync_after = (int)((PK_SYNCS >> ph) & 1ull);
}

__device__ __forceinline__ float wave_sum(float v) {
#pragma unroll
    for (int o = 32; o >= 1; o >>= 1) v += __shfl_xor(v, o);
    return v;
}

struct WJob { const float* W; const float* gain; bf16_t* Bt; int K, N, map; };
__device__ __forceinline__ WJob wjob(const Params& p, int j) {
    WJob w; w.gain = nullptr; w.map = 0;
    switch (j) {
    case 0: w.W = p.w_in_a; w.gain = p.norms + 0 * D_; w.Bt = p.BtA; w.K = D_; w.N = 5120; w.map = 1; break;
    case 1: w.W = p.w_mem_kv; w.gain = p.norms + 4 * D_; w.Bt = p.BtM; w.K = D_; w.N = 1024; break;
    case 2: w.W = p.w_mem_kv + (size_t)D_ * 1024; w.gain = p.norms + 9 * D_; w.Bt = p.BtM + (size_t)1024 * D_; w.K = D_; w.N = 1024; break;
    case 3: w.W = p.w_o_a; w.Bt = p.BtOA; w.K = 1024; w.N = D_; break;
    case 4: w.W = p.w_up; w.gain = p.norms + 2 * D_; w.Bt = p.BtUp0; w.K = D_; w.N = 2 * DFF_; w.map = 2; break;
    case 5: w.W = p.w_down; w.Bt = p.BtDn0; w.K = DFF_; w.N = D_; break;
    case 6: w.W = p.w_kv; w.gain = p.g_kv; w.Bt = p.BtB; w.K = D_; w.N = 3072; break;
    case 7: w.W = p.w_in_b; w.gain = p.norms + 5 * D_; w.Bt = p.BtB + (size_t)3072 * D_; w.K = D_; w.N = D_; break;
    case 8: w.W = p.w_o_b; w.Bt = p.BtOB; w.K = D_; w.N = D_; break;
    case 9: w.W = p.w_up + (size_t)D_ * 2 * DFF_; w.gain = p.norms + 7 * D_; w.Bt = p.BtUp1; w.K = D_; w.N = 2 * DFF_; w.map = 2; break;
    default: w.W = p.w_down + (size_t)DFF_ * D_; w.Bt = p.BtDn1; w.K = DFF_; w.N = D_; break;
    }
    return w;
}
__device__ __forceinline__ int dest_chunk(int map, int ci) {
    if (map == 1) { if (ci < 48) { const int u = ci >> 2, w = ci & 3; return 4 * u + 2 * (w & 1) + (w >> 1); } return ci; }
    if (map == 2) { if (ci < 88) return 4 * (ci >> 1) + (ci & 1); const int c2 = ci - 88; return 4 * (c2 >> 1) + 2 + (c2 & 1); }
    return ci;
}

__device__ __forceinline__ void prep_phase(const Params& p, LAS unsigned char* lds, int wave_s) {
    const int tid = opaque_tid(wave_s), lane = tid & 63, wid = tid >> 6;
    const int gw = blockIdx.x * 8 + wid, nw = gridDim.x * 8;
    for (int i = blockIdx.x * 512 + tid; i < 4 * S_; i += gridDim.x * 512) p.sumsq[i] = 0.f;
    for (int i = blockIdx.x * 512 + tid; i < S_ * 64; i += gridDim.x * 512) {
        const int pos = i >> 6, f = i & 63;
        double dinv = 1.0; for (int q = 0; q < f; ++q) dinv *= 0.8659643233600653;
        const float inv = (float)dinv;
        const float ang = (float)pos * inv;
        const double t = (double)ang * 0.15915494309189535; const float fr = (float)(t - rint(t));
        p.cs[i] = __builtin_amdgcn_cosf(fr); p.sn[i] = __builtin_amdgcn_sinf(fr);
    }
    for (int row = gw; row < S_ + NMEM_; row += nw) {
        const float* src = row < S_ ? p.x + (size_t)row * D_ : p.mem + (size_t)(row - S_) * D_;
        bf16_t* dst = row < S_ ? p.h + (size_t)row * D_ : p.hm + (size_t)(row - S_) * D_;
        f32x4 v[8]; float ss = 0.f;
#pragma unroll
        for (int i = 0; i < 8; ++i) { v[i] = *(const f32x4*)(src + 4 * (lane + 64 * i)); ss += (v[i][0] * v[i][0] + v[i][1] * v[i][1]) + (v[i][2] * v[i][2] + v[i][3] * v[i][3]); }
        ss = wave_sum(ss); const float rs = 1.0f / sqrtf(ss * (1.0f / D_) + EPS_);
#pragma unroll
        for (int i = 0; i < 8; ++i) { u32x2 w; w.x = pg8::pk2(v[i][0] * rs, v[i][1] * rs); w.y = pg8::pk2(v[i][2] * rs, v[i][3] * rs); *(u32x2*)(dst + 4 * (lane + 64 * i)) = w; }
    }
    LAS float* T = (LAS float*)lds;
    constexpr int WT[11] = {2560, 512, 512, 512, 5632, 2816, 1536, 1024, 1024, 5632, 2816};
    constexpr int total = 24576;
    for (int t = blockIdx.x; t < total; t += gridDim.x) {
        int j = 0, base = 0, accum = 0;
#pragma unroll
        for (int q = 0; q < 11; ++q) { if (t >= accum) { j = q; base = accum; } accum += WT[q]; }
        const WJob w = wjob(p, j);
        const int lt = t - base, nck = w.N / 64, ci = lt % nck, kt = lt / nck;
        {
            const int c4 = (tid & 15) * 4;
#pragma unroll
            for (int i = 0; i < 2; ++i) { const int kk = (tid >> 4) + 32 * i; const int k = kt * 64 + kk;
                f32x4 v = *(const f32x4*)(w.W + (size_t)k * w.N + ci * 64 + c4); const float g = w.gain ? w.gain[k] : 1.0f;
                T[(c4 + 0) * 65 + kk] = v[0] * g; T[(c4 + 1) * 65 + kk] = v[1] * g; T[(c4 + 2) * 65 + kk] = v[2] * g; T[(c4 + 3) * 65 + kk] = v[3] * g; }
        }
        __syncthreads();
        {   const int c = tid >> 3, k8 = (tid & 7) * 8; const int drow = dest_chunk(w.map, ci) * 64 + c;
            float f[8];
#pragma unroll
            for (int i = 0; i < 8; ++i) f[i] = T[c * 65 + k8 + i];
            u32x4 o; o.x = pg8::pk2(f[0], f[1]); o.y = pg8::pk2(f[2], f[3]); o.z = pg8::pk2(f[4], f[5]); o.w = pg8::pk2(f[6], f[7]);
            *(u32x4*)(w.Bt + (size_t)drow * w.K + kt * 64 + k8) = o;
        }
        __syncthreads();
    }
}

__device__ __forceinline__ void row_phase(const float* y, const float* sumsq, const float* g, const float* xin, float* xout, bf16_t* h, int wave_s) {
    const int tid = opaque_tid(wave_s), lane = tid & 63, wid = tid >> 6;
    f32x4 gv[8];
#pragma unroll
    for (int i = 0; i < 8; ++i) gv[i] = *(const f32x4*)(g + 4 * (lane + 64 * i));
    for (int row = blockIdx.x * 8 + wid; row < S_; row += gridDim.x * 8) {
        const float ry = 1.0f / sqrtf(sumsq[row] * (1.0f / D_) + EPS_);
        f32x4 v[8]; float ss = 0.f;
#pragma unroll
        for (int i = 0; i < 8; ++i) { const size_t o = (size_t)row * D_ + 4 * (lane + 64 * i); const f32x4 yy = *(const f32x4*)(y + o), xx = *(const f32x4*)(xin + o);
            v[i] = xx + yy * ry * gv[i]; *(f32x4*)(xout + o) = v[i]; ss += (v[i][0] * v[i][0] + v[i][1] * v[i][1]) + (v[i][2] * v[i][2] + v[i][3] * v[i][3]); }
        if (h) {
            ss = wave_sum(ss); const float rs = 1.0f / sqrtf(ss * (1.0f / D_) + EPS_);
#pragma unroll
            for (int i = 0; i < 8; ++i) { u32x2 w; w.x = pg8::pk2(v[i][0] * rs, v[i][1] * rs); w.y = pg8::pk2(v[i][2] * rs, v[i][3] * rs); *(u32x2*)(h + (size_t)row * D_ + 4 * (lane + 64 * i)) = w; }
        }
    }
}

__device__ __forceinline__ void fix_phase(bf16_t* act, const float* wconv, const float* bconv, const float* first, const float* last, int wave_s) {
    const int tid = opaque_tid(wave_s);
    for (int seg = blockIdx.x; seg < 256; seg += gridDim.x) {
        const float* f0 = first + (size_t)(seg * 2) * 2 * DFF_; const float* f1 = f0 + 2 * DFF_;
        const float* lp = last + (size_t)((seg > 0 ? seg - 1 : 0) * 2) * DFF_;
        for (int c = tid * 4; c < DFF_; c += 512 * 4) {
            const f32x4 g0 = *(const f32x4*)(f0 + c), v0 = *(const f32x4*)(f0 + DFF_ + c), g1 = *(const f32x4*)(f1 + c), v1 = *(const f32x4*)(f1 + DFF_ + c);
            f32x4 gm2 = *(const f32x4*)(lp + c), gm1 = *(const f32x4*)(lp + DFF_ + c);
            if (seg == 0) { gm2 = (f32x4){0.f, 0.f, 0.f, 0.f}; gm1 = gm2; }
            const f32x4 w0 = *(const f32x4*)(wconv + c), w1 = *(const f32x4*)(wconv + DFF_ + c), w2 = *(const f32x4*)(wconv + 2 * DFF_ + c), bc = *(const f32x4*)(bconv + c);
            const f32x4 a0 = bc + w2 * g0 + w1 * gm1 + w0 * gm2, a1 = bc + w2 * g1 + w1 * g0 + w0 * gm1;
            f32x4 o0, o1;
#pragma unroll
            for (int j = 0; j < 4; ++j) { o0[j] = a0[j] * __builtin_amdgcn_rcpf(1.0f + __builtin_amdgcn_exp2f(-1.44269504089f * a0[j])) * v0[j];
                                          o1[j] = a1[j] * __builtin_amdgcn_rcpf(1.0f + __builtin_amdgcn_exp2f(-1.44269504089f * a1[j])) * v1[j]; }
            u32x2 w; w.x = pg8::pk2(o0[0], o0[1]); w.y = pg8::pk2(o0[2], o0[3]); *(u32x2*)(act + (size_t)(seg * 64) * DFF_ + c) = w;
            w.x = pg8::pk2(o1[0], o1[1]); w.y = pg8::pk2(o1[2], o1[3]); *(u32x2*)(act + (size_t)(seg * 64 + 1) * DFF_ + c) = w;
        }
    }
}

__device__ __forceinline__ void merge_phase(const float* og, const float* lse, bf16_t* heads, int wave_s) {
    const int tid = opaque_tid(wave_s);
    for (int i = blockIdx.x * 512 + tid; i < S_ * 128; i += gridDim.x * 512) {
        const int pos = i >> 7, c = (i & 127) * 4, hh = c >> 7;
        const float l0 = lse[(size_t)pos * 4 + hh], l1 = lse[(size_t)(S_ + pos) * 4 + hh], l2 = lse[(size_t)(2 * S_ + pos) * 4 + hh];
        const float mx = fmaxf(l0, fmaxf(l1, l2));
        float e0 = __builtin_amdgcn_exp2f(l0 - mx), e1 = __builtin_amdgcn_exp2f(l1 - mx), e2 = __builtin_amdgcn_exp2f(l2 - mx);
        const float inv = 1.0f / (e0 + e1 + e2); e0 *= inv; e1 *= inv; e2 *= inv;
        const f32x4 a = *(const f32x4*)(og + (size_t)pos * 512 + c), b = *(const f32x4*)(og + (size_t)(S_ + pos) * 512 + c), d = *(const f32x4*)(og + (size_t)(2 * S_ + pos) * 512 + c);
        const f32x4 o = a * e0 + b * e1 + d * e2;
        u32x2 w; w.x = pg8::pk2(o[0], o[1]); w.y = pg8::pk2(o[2], o[3]); *(u32x2*)(heads + (size_t)pos * 1024 + c) = w;
    }
}

struct AttnItem {
    const bf16_t* q; const bf16_t* k; const bf16_t* v; long qp, kp;
    int mode;
    int t0, t1, tstep;
    int nb0;
    bf16_t* ob; long obp; float* of; long ofp; float* ol; long olp;
};
__device__ __forceinline__ unsigned offb(unsigned row, unsigned ch) { return 256u * row + 16u * (ch ^ (((row & 3u) << 2) | ((row >> 2) & 3u))); }

__device__ __forceinline__ void attn_stage(LAS unsigned char* lds, unsigned bufoff, const bf16_t* base, long pitch, int tile, int tid, int wid) {
#pragma unroll
    for (int i = 0; i < 4; ++i) {
        const unsigned row = i * 32 + (tid >> 4), pch = tid & 15, ch = pch ^ (((row & 3u) << 2) | ((row >> 2) & 3u));
        const bf16_t* g = base + (size_t)(tile * 128 + (int)row) * pitch + ch * 8;
        __builtin_amdgcn_global_load_lds((const unsigned*)g, (LAS unsigned*)(lds + bufoff + i * 8192 + wid * 1024), 16, 0, 0);
    }
}

template <int MODE> __device__ __forceinline__ void attn_item(const AttnItem& it, LAS unsigned char* lds, int wave_s) {
    const int tid = opaque_tid(wave_s), wid = __builtin_amdgcn_readfirstlane(tid >> 6), lane = tid & 63, r = lane & 31, h = lane >> 5;
    constexpr unsigned KB0 = 0, VB0 = 65536;
    LAS unsigned* flags = (LAS unsigned*)(lds + pg8::STAGE_BYTES);
    const float sc2 = 0.08838834764831845f * 1.4426950408889634f;
    const int myblk = it.nb0 + (wid >> 2);
    const int nq = myblk * 128 + (wid & 3) * 32 + r;
    bf16x8 qf[8];
    { const bf16_t* qrow = it.q + (size_t)(wid * 32 + r) * it.qp + 8 * h;
#pragma unroll
      for (int s = 0; s < 8; ++s) qf[s] = *(const bf16x8*)(qrow + 16 * s); }
    f32x16 o[4];
#pragma unroll
    for (int d = 0; d < 4; ++d)
#pragma unroll
        for (int i = 0; i < 16; ++i) o[d][i] = 0.f;
    float mrun = -1e30f, lrun = 0.f, carry = 1.0f;
    const unsigned sw = ((r & 3u) << 2) | ((r >> 2) & 3u);
    const unsigned q4 = (lane & 15) >> 2, p4 = lane & 3, blk = (lane >> 4) & 1;
    unsigned vlo[4], vhi[4];
#pragma unroll
    for (int d = 0; d < 4; ++d) { const unsigned chv = 4u * d + 2u * blk + (p4 >> 1); vlo[d] = offb(4u * h + q4, chv) + 8u * (p4 & 1); vhi[d] = offb(4u * h + q4 + 8u, chv) + 8u * (p4 & 1); }
    unsigned kad[8];
#pragma unroll
    for (int ks = 0; ks < 8; ++ks) kad[ks] = 256u * r + 16u * (((unsigned)(2 * ks) + h) ^ sw);

    int t = it.t0, cur = 0;
    attn_stage(lds, KB0, it.k, it.kp, t, tid, wid); attn_stage(lds, VB0, it.v, it.kp, t, tid, wid);
    asm volatile("s_waitcnt vmcnt(0)" ::: "memory"); __builtin_amdgcn_s_barrier(); asm volatile("" ::: "memory");
    for (;;) {
        const bool has_next = (t != it.t1);
        if (has_next) { attn_stage(lds, KB0 + (cur ^ 1) * 32768, it.k, it.kp, t + it.tstep, tid, wid); attn_stage(lds, VB0 + (cur ^ 1) * 32768, it.v, it.kp, t + it.tstep, tid, wid); }
        const unsigned kbuf = KB0 + cur * 32768, vbuf = VB0 + cur * 32768;
        bool relevant;
        if (MODE == 0) relevant = true; else if (MODE == 1) relevant = (t == myblk || t == myblk - 1); else relevant = (t <= myblk);
        if (relevant) {
            const bool diag = (t == myblk);
            const int iq = (wid & 3) * 32 + r;
#pragma unroll 1
            for (int hf = 1; hf >= 0; --hf) {
                const unsigned hoff = (unsigned)hf * 16384u;
                f32x16 s[2];
#pragma unroll
                for (int kb = 0; kb < 2; ++kb) {
#pragma unroll
                    for (int i = 0; i < 16; ++i) s[kb][i] = 0.f;
#pragma unroll
                    for (int ks = 0; ks < 8; ++ks) {
                        const bf16x8 kf = *(const LAS bf16x8*)(lds + kbuf + hoff + kad[ks] + kb * 8192);
                        s[kb] = __builtin_amdgcn_mfma_f32_32x32x16_bf16(kf, qf[ks], s[kb], 0, 0, 0);
                    }
                }
                if (MODE != 2) {
                    float mx = -1e30f;
#pragma unroll
                    for (int kb = 0; kb < 2; ++kb)
#pragma unroll
                        for (int i = 0; i < 16; ++i) {
                            float xv = s[kb][i] * sc2;
                            if (MODE == 1) { const int m = t * 128 + hf * 64 + kb * 32 + (i & 3) + 8 * (i >> 2) + 4 * h; const int rel = nq - m; if (rel < 0 || rel > 128) xv = -1e30f; }
                            s[kb][i] = xv; mx = fmaxf(mx, xv);
                        }
                    mx = fmaxf(mx, __shfl_xor(mx, 32));
                    const float mnew = fmaxf(mrun, mx), alpha = __builtin_amdgcn_exp2f(mrun - mnew);
                    float ls = 0.f;
#pragma unroll
                    for (int kb = 0; kb < 2; ++kb)
#pragma unroll
                        for (int i = 0; i < 16; ++i) { const float pv = (s[kb][i] > -1e29f) ? __builtin_amdgcn_exp2f(s[kb][i] - mnew) : 0.f; s[kb][i] = pv; ls += pv; }
                    ls += __shfl_xor(ls, 32);
                    lrun = lrun * alpha + ls; mrun = mnew;
#pragma unroll
                    for (int d = 0; d < 4; ++d)
#pragma unroll
                        for (int i = 0; i < 16; ++i) o[d][i] *= alpha;
                } else {
#pragma unroll
                    for (int kb = 1; kb >= 0; --kb) {
                        float G[4], GP[4];
#pragma unroll
                        for (int i = 0; i < 16; ++i) {
                            const float e = __builtin_amdgcn_exp2f(s[kb][i] * sc2);
                            float kp = __builtin_amdgcn_rcpf(1.0f + e);
                            if (diag) { const int kl = hf * 64 + kb * 32 + (i & 3) + 8 * (i >> 2) + 4 * h; if (kl >= iq) kp = 1.0f; }
                            s[kb][i] = kp;
                        }
#pragma unroll
                        for (int g = 0; g < 4; ++g) { G[g] = (s[kb][4 * g] * s[kb][4 * g + 1]) * (s[kb][4 * g + 2] * s[kb][4 * g + 3]); GP[g] = __shfl_xor(G[g], 32); }
                        float R = carry;
#pragma unroll
                        for (int g = 3; g >= 0; --g) {
                            float w = (h == 0) ? R * GP[g] : R;
                            R *= G[g] * GP[g];
#pragma unroll
                            for (int j = 3; j >= 0; --j) { const float kp = s[kb][4 * g + j]; s[kb][4 * g + j] = (1.0f - kp) * w; w *= kp; }
                        }
                        carry = R;
                    }
                }
#pragma unroll
                for (int kb = 0; kb < 2; ++kb)
#pragma unroll
                    for (int s2 = 0; s2 < 2; ++s2) {
                        u32x4 pw; pw.x = pg8::pk2(s[kb][8 * s2 + 0], s[kb][8 * s2 + 1]); pw.y = pg8::pk2(s[kb][8 * s2 + 2], s[kb][8 * s2 + 3]);
                        pw.z = pg8::pk2(s[kb][8 * s2 + 4], s[kb][8 * s2 + 5]); pw.w = pg8::pk2(s[kb][8 * s2 + 6], s[kb][8 * s2 + 7]);
                        const bf16x8 pf = __builtin_bit_cast(bf16x8, pw);
#pragma unroll
                        for (int d = 0; d < 4; ++d) {
                            const s16x4 lo = __builtin_amdgcn_ds_read_tr16_b64_v4i16((LAS s16x4*)(lds + vbuf + hoff + vlo[d] + kb * 8192 + s2 * 4096));
                            const s16x4 hi = __builtin_amdgcn_ds_read_tr16_b64_v4i16((LAS s16x4*)(lds + vbuf + hoff + vhi[d] + kb * 8192 + s2 * 4096));
                            const bf16x8 vf = __builtin_shufflevector(lo, hi, 0, 1, 2, 3, 4, 5, 6, 7);
                            o[d] = __builtin_amdgcn_mfma_f32_32x32x16_bf16(vf, pf, o[d], 0, 0, 0);
                        }
                    }
            }
        }
        if (MODE == 2) { const unsigned long long bal = __ballot(carry != 0.0f); if (lane == 0) flags[(t & 1) * 8 + wid] = (bal != 0ull) ? 1u : 0u; }
        asm volatile("s_waitcnt vmcnt(0) lgkmcnt(0)" ::: "memory"); __builtin_amdgcn_s_barrier(); asm volatile("" ::: "memory");
        if (!has_next) break;
        if (MODE == 2) { unsigned any = 0;
#pragma unroll
            for (int w = 0; w < 8; ++w) any |= flags[(t & 1) * 8 + w];
            if (__builtin_amdgcn_readfirstlane(any) == 0u) break; }
        t += it.tstep; cur ^= 1;
    }
    const int qi = wid * 32 + r;
    if (MODE == 1) {
        const float inv = 1.0f / lrun;
        float* orow = it.of + (size_t)qi * it.ofp;
#pragma unroll
        for (int d = 0; d < 4; ++d)
#pragma unroll
            for (int g = 0; g < 4; ++g) { f32x4 v; v[0] = o[d][4 * g] * inv; v[1] = o[d][4 * g + 1] * inv; v[2] = o[d][4 * g + 2] * inv; v[3] = o[d][4 * g + 3] * inv;
                *(f32x4*)(orow + 32 * d + 8 * g + 4 * h) = v; }
        if (h == 0) it.ol[(size_t)qi * it.olp] = mrun + __builtin_amdgcn_logf(lrun);
    } else {
        const float inv = (MODE == 0) ? 1.0f / lrun : 1.0f;
        bf16_t* orow = it.ob + (size_t)qi * it.obp;
#pragma unroll
        for (int d = 0; d < 4; ++d)
#pragma unroll
            for (int g = 0; g < 4; ++g) { u32x2 w; w.x = pg8::pk2(o[d][4 * g] * inv, o[d][4 * g + 1] * inv); w.y = pg8::pk2(o[d][4 * g + 2] * inv, o[d][4 * g + 3] * inv);
                *(u32x2*)(orow + 32 * d + 8 * g + 4 * h) = w; }
    }
}

__device__ __forceinline__ void attn_phase(const Params& p, int layer, LAS unsigned char* lds, int wave_s) {
    const int nitems = 768 + 256;
    for (int item = blockIdx.x; item < nitems; item += gridDim.x) {
        AttnItem it;
        it.ob = nullptr; it.obp = 0; it.of = nullptr; it.ofp = 0; it.ol = nullptr; it.olp = 0; it.tstep = 1; it.nb0 = 0;
        if (item >= 768) {
            const int mi = item - 768, hm = mi & 3, qb = mi >> 2;
            it.mode = 0; it.t0 = 0; it.t1 = 1;
            it.q = p.big + (size_t)(qb * 256) * 5120 + 4608 + hm * 128; it.qp = 5120;
            it.k = p.mkv + layer * 1024 + hm * 128; it.v = it.k + 512; it.kp = 2048;
            if (layer == 0) { it.ob = p.heads + (size_t)(qb * 256) * 1024 + 512 + hm * 128; it.obp = 1024; }
            else { it.ob = p.heads + (size_t)(qb * 256) * 2048 + 1536 + hm * 128; it.obp = 2048; }
        } else if (layer == 0) {
            const int g = item >> 8, li = item & 255, hh = li & 3, rest = li >> 2;
            const int dl = (g == 0) ? 1 : (g == 1 ? 4 : 16), npair = 64 / dl, rs = rest / npair, pr = rest % npair;
            const int hd = g * 4 + hh;
            it.mode = 1; it.nb0 = 2 * pr; it.t0 = (pr == 0) ? 0 : 2 * pr - 1; it.t1 = 2 * pr + 1;
            const size_t prow = (size_t)(pr * 256) * dl + rs;
            it.q = p.big + prow * 5120 + hd * 128; it.qp = (long)dl * 5120;
            it.k = p.big + (size_t)rs * 5120 + 1536 + hd * 128; it.v = it.k + 1536; it.kp = (long)dl * 5120;
            it.of = p.y + (size_t)g * S_ * 512 + prow * 512 + hh * 128; it.ofp = (long)dl * 512;
            it.ol = p.lse + (size_t)g * S_ * 4 + prow * 4 + hh; it.olp = (long)dl * 4;
        } else {
            const int hd = item % 12, qb = item / 12;
            it.mode = 2; it.nb0 = 2 * qb; it.t0 = 2 * qb + 1; it.t1 = 0; it.tstep = -1;
            it.q = p.big + (size_t)(qb * 256) * 5120 + 3072 + hd * 128; it.qp = 5120;
            it.k = p.big + hd * 128; it.v = it.k + 1536; it.kp = 5120;
            it.ob = p.heads + (size_t)(qb * 256) * 2048 + hd * 128; it.obp = 2048;
        }
        if (it.mode == 0) attn_item<0>(it, lds, wave_s); else if (it.mode == 1) attn_item<1>(it, lds, wave_s); else attn_item<2>(it, lds, wave_s);
    }
}

__global__ __launch_bounds__(512, 2) void yoco_forward(Params p, int ph0, int ph1) {
    extern __shared__ __attribute__((aligned(16))) unsigned char shm[];
    LAS unsigned char* lds = (LAS unsigned char*)shm;
    const int wave_s = __builtin_amdgcn_readfirstlane((int)(threadIdx.x >> 6));
    for (int ph = ph0; ph < ph1; ++ph) {
        int kind, var, sync_after; phase_info(ph, kind, var, sync_after);
#ifndef ONLY_KIND
#define EN(k) true
#else
#define EN(k) ((k) == ONLY_KIND)
#endif
        if (kind == K_PREP && EN(K_PREP)) {
            prep_phase(p, lds, wave_s);
        } else if (kind == K_GPROJ && EN(K_GPROJ)) {
            pg8::Gemm g; pg8::EpiProj E; E.cs = p.cs; E.sn = p.sn;
            if (var == 0) { g.A = p.h; g.Bt = p.BtA; g.M = S_; g.N = 5120; g.K = D_; E.O = p.big; E.ldc = 5120; E.rope_units = 12; }
            else if (var == 1) { g.A = p.hm; g.Bt = p.BtM; g.M = NMEM_; g.N = 2048; g.K = D_; E.O = p.mkv; E.ldc = 2048; E.rope_units = 0; }
            else { g.A = p.h; g.Bt = p.BtB; g.M = S_; g.N = 5120; g.K = D_; E.O = p.big; E.ldc = 5120; E.rope_units = 0; }
            pg8::StaticOrder S; S.init(g.M, g.N, (int)gridDim.x, (int)blockIdx.x);
            pg8::gemm_phase<pg8::EpiProj, pg8::StaticOrder, false>(lds, g, S, E, nullptr, wave_s);
        } else if (kind == K_ATTN && EN(K_ATTN)) {
            attn_phase(p, var, lds, wave_s);
        } else if (kind == K_MERGE && EN(K_MERGE)) {
            merge_phase(p.y, p.lse, p.heads, wave_s);
        } else if (kind == K_GY && EN(K_GY)) {
            pg8::Gemm g; pg8::EpiY E; E.C = p.y; E.ldc = D_; E.sumsq = p.sumsq + var * S_; g.M = S_; g.N = D_;
            if (var == 0) { g.A = p.heads; g.Bt = p.BtOA; g.K = 1024; }
            else if (var == 1) { g.A = p.big; g.Bt = p.BtDn0; g.K = DFF_; }
            else if (var == 2) { g.A = p.heads; g.Bt = p.BtOB; g.K = D_; }
            else { g.A = p.big; g.Bt = p.BtDn1; g.K = DFF_; }
            pg8::StaticOrder S; S.init(g.M, g.N, (int)gridDim.x, (int)blockIdx.x);
            pg8::gemm_phase<pg8::EpiY, pg8::StaticOrder, false>(lds, g, S, E, nullptr, wave_s);
        } else if (kind == K_ROW && EN(K_ROW)) {
            const int layer = var >> 1, which = var & 1;
            row_phase(p.y, p.sumsq + var * S_, p.norms + (size_t)(layer * 5 + (which ? 3 : 1)) * D_, var == 0 ? p.x : p.out, p.out, var == 3 ? nullptr : p.h, wave_s);
        } else if (kind == K_GUP && EN(K_GUP)) {
            pg8::Gemm g; g.A = p.h; g.Bt = var ? p.BtUp1 : p.BtUp0; g.M = S_; g.N = 2 * DFF_; g.K = D_;
            pg8::EpiUp E; E.act = p.big; E.wconv = p.w_conv + (size_t)var * 3 * DFF_; E.bconv = p.b_conv + (size_t)var * DFF_; E.first = p.y; E.last = p.y + (size_t)256 * 4 * DFF_;
            pg8::StaticOrder S; S.init(g.M, g.N, (int)gridDim.x, (int)blockIdx.x);
            pg8::gemm_phase<pg8::EpiUp, pg8::StaticOrder, false>(lds, g, S, E, nullptr, wave_s);
        } else if (EN(K_FIX)) {
            fix_phase(p.big, p.w_conv + (size_t)var * 3 * DFF_, p.b_conv + (size_t)var * DFF_, p.y, p.y + (size_t)256 * 4 * DFF_, wave_s);
        }
        if (sync_after && ph + 1 < ph1) { if (p.coop) cooperative_groups::this_grid().sync(); }
    }
}

#ifndef MK_LAUNCHES
#define MK_LAUNCHES 1
#endif

extern "C" void kernel_launch(void* const* d_in, const int* in_sizes, int n_in, void* d_out, int out_size, void* d_ws, size_t ws_size, hipStream_t stream) {
    (void)in_sizes; (void)n_in; (void)out_size;
    Params p{};
    p.x = (const float*)d_in[0]; p.mem = (const float*)d_in[1]; p.norms = (const float*)d_in[2]; p.w_in_a = (const float*)d_in[3]; p.w_o_a = (const float*)d_in[4];
    p.g_kv = (const float*)d_in[5]; p.w_kv = (const float*)d_in[6]; p.w_in_b = (const float*)d_in[7]; p.w_o_b = (const float*)d_in[8]; p.w_mem_kv = (const float*)d_in[9];
    p.w_up = (const float*)d_in[10]; p.w_conv = (const float*)d_in[11]; p.b_conv = (const float*)d_in[12]; p.w_down = (const float*)d_in[13];
    p.out = (float*)d_out;
    unsigned char* w = (unsigned char*)d_ws; size_t off = 0;
    auto take = [&](size_t bytes) { unsigned char* r = w + off; off += (bytes + 255) & ~(size_t)255; return r; };
    p.BtA = (bf16_t*)take((size_t)5120 * D_ * 2); p.BtM = (bf16_t*)take((size_t)2048 * D_ * 2); p.BtOA = (bf16_t*)take((size_t)D_ * 1024 * 2);
    p.BtUp0 = (bf16_t*)take((size_t)2 * DFF_ * D_ * 2); p.BtDn0 = (bf16_t*)take((size_t)D_ * DFF_ * 2); p.BtB = (bf16_t*)take((size_t)5120 * D_ * 2);
    p.BtOB = (bf16_t*)take((size_t)D_ * D_ * 2); p.BtUp1 = (bf16_t*)take((size_t)2 * DFF_ * D_ * 2); p.BtDn1 = (bf16_t*)take((size_t)D_ * DFF_ * 2);
    p.cs = (float*)take((size_t)S_ * 64 * 4); p.sn = (float*)take((size_t)S_ * 64 * 4);
    p.h = (bf16_t*)take((size_t)S_ * D_ * 2); p.hm = (bf16_t*)take((size_t)NMEM_ * D_ * 2); p.mkv = (bf16_t*)take((size_t)NMEM_ * 2048 * 2);
    p.big = (bf16_t*)take((size_t)S_ * DFF_ * 2); p.heads = (bf16_t*)take((size_t)S_ * D_ * 2);
    p.y = (float*)take((size_t)S_ * D_ * 4); p.lse = (float*)take((size_t)3 * S_ * 4 * 4); p.sumsq = (float*)take((size_t)4 * S_ * 4);
    if (off > ws_size) { fprintf(stderr, "workspace too small: need %zu have %zu\n", off, ws_size); return; }
    static int grid_blocks = 0;
    if (!grid_blocks) {
        int dev = 0, cus = 0, per_cu = 0;
        hipGetDevice(&dev); hipDeviceGetAttribute(&cus, hipDeviceAttributeMultiprocessorCount, dev);
        hipFuncSetAttribute((const void*)yoco_forward, hipFuncAttributeMaxDynamicSharedMemorySize, LDS_BYTES);
        hipOccupancyMaxActiveBlocksPerMultiprocessor(&per_cu, yoco_forward, 512, LDS_BYTES);
        if (per_cu < 1) per_cu = 1;
        grid_blocks = cus * per_cu;
    }
#if MK_LAUNCHES
    p.coop = 0;
    int ph = 0;
    while (ph < NPHASE) {
        int e = ph; for (;;) { int kind, var, sy; phase_info(e, kind, var, sy); ++e; if (sy || e >= NPHASE) break; }
        hipLaunchKernelGGL(yoco_forward, dim3(grid_blocks), dim3(512), LDS_BYTES, stream, p, ph, e);
        ph = e;
    }
#else
    p.coop = 1;
    int ph0 = 0, ph1 = NPHASE;
    void* args[] = {&p, &ph0, &ph1};
    hipError_t e = hipLaunchCooperativeKernel((const void*)yoco_forward, dim3(grid_blocks), dim3(512), args, LDS_BYTES, stream);
    if (e != hipSuccess) fprintf(stderr, "cooperative launch failed: %s (grid %d)\n", hipGetErrorString(e), grid_blocks);
#endif
}
```

```cpp
#include <hip/hip_runtime.h>
#include <hip/hip_cooperative_groups.h>
#include <cstdio>
__device__ __forceinline__ int opaque_tid(int wave_s) { unsigned m = ~0u; asm volatile("" : "+s"(m)); int w = wave_s; asm volatile("" : "+s"(w));
    int t = w * 64 + (int)__builtin_amdgcn_mbcnt_hi(m, __builtin_amdgcn_mbcnt_lo(m, 0u)); asm volatile("" : "+v"(t)); return t; }
__device__ __forceinline__ int opaque_bid() { int b = (int)blockIdx.x; asm volatile("" : "+s"(b)); return b; }
namespace pg8 {
#define PG8_LAS __attribute__((address_space(3)))
typedef unsigned short bf16_t;
typedef short bf16x8 __attribute__((ext_vector_type(8)));
typedef float f32x4 __attribute__((ext_vector_type(4)));
typedef unsigned u32x4 __attribute__((ext_vector_type(4)));
constexpr int BM = 256, BK = 64, HALF = 128, HTB = HALF * BK * 2  , STAGE_BYTES = 8 * HTB, NXCD = 8, WGM = 8;

__host__ __device__ __forceinline__ int lds_byte(int r, int c) { const int st = (r >> 4) * 2 + (c >> 5), rr = r & 15, cc = c & 31, ob = rr * 64 + cc * 2; return st * 1024 + (ob ^ (((ob >> 9) & 1) << 5)); }
__host__ __device__ __forceinline__ void stage_rc(int b, int& R, int& C) { const int st = b / 1024, sb = b % 1024, swz = sb ^ (((sb >> 9) & 1) << 5); R = (st >> 1) * 16 + swz / 64; C = (st & 1) * 32 + (swz % 64) / 2; }
__host__ __device__ __forceinline__ int perm32(int rho) { const int n = rho >> 4, i = rho & 15; return 8 * (i >> 2) + 4 * n + (i & 3); }


struct Unit { int pm, pn; };
struct Gemm { const bf16_t* A; const bf16_t* Bt; int M, N, K; };
struct StaticOrder {
    int nM, nN, nwg, G, c;
    __host__ __device__ void init(int M, int N, int G_, int c_) { nM = M / BM; nN = N / BM; nwg = nM * nN; G = G_; c = c_; }
    __host__ __device__ bool next(int i, Unit& u) const {
        const long L = (long)i * G + c; if (L >= nwg) return false;
        int wgid = (int)L; { const int q = nwg / NXCD, r = nwg % NXCD, xcd = wgid % NXCD, off = wgid / NXCD; wgid = (xcd < r ? xcd * (q + 1) : r * (q + 1) + (xcd - r) * q) + off; }
        const int nig = WGM * nN, gid = wgid / nig, fm = gid * WGM, gsz = (nM - fm) < WGM ? (nM - fm) : WGM;
        u.pm = fm + ((wgid % nig) % gsz); u.pn = (wgid % nig) / gsz; return true;
    }
    __device__ __forceinline__ void a_ready(const Unit&) const {}
    __device__ __forceinline__ void done(const Unit&) const {}
};

template <class Epi, class Sched, bool STAMP = false>
__device__ __forceinline__ void gemm_phase(PG8_LAS unsigned char* lds, const Gemm g, const Sched& S, const Epi& E, unsigned long long* stamps, int wave_s) {
    const int tid = opaque_tid(wave_s), wid = __builtin_amdgcn_readfirstlane(tid >> 6), lane = tid & 63, wr = wid >> 2, wc = wid & 3, fr = lane & 15, fq = lane >> 4;
    const int K = g.K, nt = K / BK;
    int ts_lo = 0, ts_hi = 0, nts = 0; const unsigned long long rt_entry = STAMP ? (unsigned long long)wall_clock64() : 0ull;
#define PG8_STAMP() do { if (STAMP && wid == 0 && nts < 64) { const unsigned long long _c = (unsigned long long)clock64(); \
        ts_lo = (lane == nts) ? (int)(unsigned)_c : ts_lo; ts_hi = (lane == nts) ? (int)(unsigned)(_c >> 32) : ts_hi; ++nts; } } while (0)
    PG8_STAMP();
    unsigned voffA[2], voffB[2];
#pragma unroll
    for (int i = 0; i < 2; ++i) { int R, C; stage_rc(tid * 16 + i * 8192, R, C); const int Rb = Epi::PERM ? ((R & ~31) + perm32(R & 31)) : R;
        voffA[i] = (unsigned)(R * K + C) * 2u; voffB[i] = (unsigned)(Rb * K + C) * 2u; }
    const size_t kstep = (size_t)(BK * 2);
    const size_t hstep = (size_t)HALF * K * 2;
    const size_t tstep = 2 * hstep;
    const unsigned ldsw = (unsigned)wid * 1024u;
    const int aoff = lds_byte(wr * 64 + fr, fq * 8), boff = lds_byte(wc * 32 + fr, fq * 8);
#define PG8_SA(b, h) (((b) * 2 + (h)) * HTB)
#define PG8_SB(b, h) ((4 + (b) * 2 + (h)) * HTB)
#define PG8_STAGE(bufoff, gbase, voff) do { _Pragma("unroll") for (int _i = 0; _i < 2; ++_i) \
        __builtin_amdgcn_global_load_lds((const unsigned*)((const char*)(gbase) + (voff)[_i]), (PG8_LAS unsigned*)(lds + (bufoff) + ldsw + _i * 8192), 16, 0, 0); } while (0)
#define PG8_LDA(dst, b, h) do { _Pragma("unroll") for (int m = 0; m < 4; ++m) _Pragma("unroll") for (int k = 0; k < 2; ++k) dst[m][k] = *(const PG8_LAS bf16x8*)(lds + PG8_SA(b, h) + aoff + m * 2048 + k * 1024); } while (0)
#define PG8_LDB(dst, b, h) do { _Pragma("unroll") for (int n = 0; n < 2; ++n) _Pragma("unroll") for (int k = 0; k < 2; ++k) dst[n][k] = *(const PG8_LAS bf16x8*)(lds + PG8_SB(b, h) + boff + n * 2048 + k * 1024); } while (0)
#define PG8_MMA(ai, bj, At, Bt) do { __builtin_amdgcn_s_setprio(1); _Pragma("unroll") for (int k = 0; k < 2; ++k) _Pragma("unroll") for (int m = 0; m < 4; ++m) _Pragma("unroll") for (int n = 0; n < 2; ++n) \
        acc[ai][bj][m][n] = __builtin_amdgcn_mfma_f32_16x16x32_bf16(Bt[n][k], At[m][k], acc[ai][bj][m][n], 0, 0, 0); __builtin_amdgcn_s_setprio(0); } while (0)
#define PG8_MMA2(ai, b0j, b1j, At, Bt0, Bt1) do { \
        _Pragma("unroll") for (int k = 0; k < 2; ++k) _Pragma("unroll") for (int m = 0; m < 4; ++m) _Pragma("unroll") for (int n = 0; n < 2; ++n) \
            acc[ai][b0j][m][n] = __builtin_amdgcn_mfma_f32_16x16x32_bf16(Bt0[n][k], At[m][k], acc[ai][b0j][m][n], 0, 0, 0); \
        _Pragma("unroll") for (int k = 0; k < 2; ++k) _Pragma("unroll") for (int m = 0; m < 4; ++m) _Pragma("unroll") for (int n = 0; n < 2; ++n) \
            acc[ai][b1j][m][n] = __builtin_amdgcn_mfma_f32_16x16x32_bf16(Bt1[n][k], At[m][k], acc[ai][b1j][m][n], 0, 0, 0); \
        __builtin_amdgcn_s_setprio(0); } while (0)
#define PG8_WAIT_V(n) asm volatile("s_waitcnt vmcnt(" #n ")" ::: "memory")
#define PG8_WAIT_L(n) asm volatile("s_waitcnt lgkmcnt(" #n ")" ::: "memory")
#define PG8_BAR __builtin_amdgcn_s_barrier()
#define PG8_SCHED __builtin_amdgcn_sched_barrier(0)
    Unit cur, nxt; int ui = 0;
    if (!S.next(0, cur)) return;
    f32x4 acc[2][2][4][2];
#pragma unroll
    for (int a = 0; a < 2; ++a)
#pragma unroll
        for (int b = 0; b < 2; ++b)
#pragma unroll
            for (int m = 0; m < 4; ++m)
#pragma unroll
                for (int n = 0; n < 2; ++n) acc[a][b][m][n] = (f32x4){0.f, 0.f, 0.f, 0.f};
    bf16x8 At[4][2], B0[2][2], B1[2][2];
    const char* cA = (const char*)g.A + (size_t)cur.pm * tstep; const char* cB = (const char*)g.Bt + (size_t)cur.pn * tstep;
    S.a_ready(cur);
    PG8_STAGE(PG8_SB(0, 0), cB, voffB); PG8_STAGE(PG8_SA(0, 0), cA, voffA); PG8_STAGE(PG8_SB(0, 1), cB + hstep, voffB); PG8_STAGE(PG8_SA(0, 1), cA + hstep, voffA);
    PG8_STAGE(PG8_SB(1, 0), cB + kstep, voffB); PG8_STAGE(PG8_SA(1, 0), cA + kstep, voffA); PG8_STAGE(PG8_SB(1, 1), cB + hstep + kstep, voffB);
    PG8_WAIT_V(6);
    if (wr == 1) PG8_BAR;
    PG8_BAR;
    PG8_STAMP();
    for (;;) {
        const bool has_next = S.next(ui + 1, nxt);
        const char* nA = has_next ? (const char*)g.A + (size_t)nxt.pm * tstep : cA; const char* nB = has_next ? (const char*)g.Bt + (size_t)nxt.pn * tstep : cB;
        for (int t = 0; t < nt; t += 2) {
            const bool last = (t == nt - 2);
            const char* a1 = cA + (size_t)(t + 1) * kstep;
            const char* a2 = last ? nA : cA + (size_t)(t + 2) * kstep; const char* b2 = last ? nB : cB + (size_t)(t + 2) * kstep;
            const char* a3 = a2 + kstep; const char* b3 = b2 + kstep;
            if (last && has_next) S.a_ready(nxt);
            PG8_LDB(B0, 0, 0); PG8_LDA(At, 0, 0); PG8_LDB(B1, 0, 1); PG8_STAGE(PG8_SA(1, 1), a1 + hstep, voffA);
            PG8_WAIT_L(0); PG8_WAIT_V(8); __builtin_amdgcn_s_setprio(1); PG8_BAR; PG8_MMA2(0, 0, 1, At, B0, B1); PG8_BAR; PG8_SCHED;
            PG8_LDA(At, 0, 1); PG8_STAGE(PG8_SB(0, 0), b2, voffB); PG8_STAGE(PG8_SA(0, 0), a2, voffA); PG8_STAGE(PG8_SB(0, 1), b2 + hstep, voffB);
            PG8_WAIT_L(0); PG8_WAIT_V(8); __builtin_amdgcn_s_setprio(1); PG8_BAR; PG8_MMA2(1, 0, 1, At, B0, B1); PG8_BAR; PG8_SCHED;
            PG8_LDB(B0, 1, 0); PG8_LDA(At, 1, 0); PG8_LDB(B1, 1, 1); PG8_STAGE(PG8_SA(0, 1), a2 + hstep, voffA);
            PG8_WAIT_L(0); PG8_WAIT_V(8); __builtin_amdgcn_s_setprio(1); PG8_BAR; PG8_MMA2(0, 0, 1, At, B0, B1); PG8_BAR; PG8_SCHED;
            PG8_LDA(At, 1, 1); PG8_STAGE(PG8_SB(1, 0), b3, voffB); PG8_STAGE(PG8_SA(1, 0), a3, voffA); PG8_STAGE(PG8_SB(1, 1), b3 + hstep, voffB);
            PG8_WAIT_L(0); PG8_WAIT_V(8); __builtin_amdgcn_s_setprio(1); PG8_BAR; PG8_MMA2(1, 0, 1, At, B0, B1); PG8_BAR; PG8_SCHED;
        }
        PG8_STAMP();
        if constexpr (!Epi::AFTER_DRAIN) { E(acc, cur, wr, wc, fr, fq); S.done(cur); }
        PG8_STAMP();
        if (!has_next) break;
#pragma unroll
        for (int a = 0; a < 2; ++a)
#pragma unroll
            for (int b = 0; b < 2; ++b)
#pragma unroll
                for (int m = 0; m < 4; ++m)
#pragma unroll
                    for (int n = 0; n < 2; ++n) acc[a][b][m][n] = (f32x4){0.f, 0.f, 0.f, 0.f};
        cur = nxt; cA = nA; cB = nB; ++ui;
    }
    PG8_WAIT_V(0);
    if (wr == 0) PG8_BAR;
    PG8_BAR;
    if constexpr (Epi::AFTER_DRAIN) { E.fused(acc, cur, wr, wc, fr, fq, lds, wid, lane); S.done(cur); }
    PG8_STAMP();
    if (STAMP && wid == 0) { stamps[lane] = lane < nts ? (((unsigned long long)(unsigned)ts_hi << 32) | (unsigned)ts_lo) : 0ull;
        if (lane == 62) stamps[62] = rt_entry; if (lane == 63) stamps[63] = (unsigned long long)wall_clock64(); }
#undef PG8_STAMP
#undef PG8_SA
#undef PG8_SB
#undef PG8_STAGE
#undef PG8_LDA
#undef PG8_LDB
#undef PG8_MMA
#undef PG8_MMA2
#undef PG8_WAIT_V
#undef PG8_WAIT_L
#undef PG8_BAR
#undef PG8_SCHED
}

typedef __bf16 nbf2 __attribute__((ext_vector_type(2)));
typedef float f32x2n __attribute__((ext_vector_type(2)));
typedef unsigned u32x2 __attribute__((ext_vector_type(2)));
__device__ __forceinline__ unsigned pk2(float lo, float hi) { return __builtin_bit_cast(unsigned, __builtin_convertvector((f32x2n){lo, hi}, nbf2)); }
__device__ __forceinline__ u32x4 pk8(const f32x4& a, const f32x4& b) { u32x4 w; w.x = pk2(a[0], a[1]); w.y = pk2(a[2], a[3]); w.z = pk2(b[0], b[1]); w.w = pk2(b[2], b[3]); return w; }

template <int CTRL> __device__ __forceinline__ float ror16(float x) { return __builtin_bit_cast(float, __builtin_amdgcn_update_dpp(0, __builtin_bit_cast(int, x), CTRL, 0xf, 0xf, false)); }

struct EpiProj {
    static constexpr bool PERM = true, AFTER_DRAIN = false;
    bf16_t* O; int ldc; int rope_units; const float* cs; const float* sn; const float* rstd;
    __device__ __forceinline__ void operator()(const f32x4 (&acc)[2][2][4][2], const Unit& u, int wr, int wc, int fr, int fq) const {
        const int row0 = u.pm * BM + wr * 64 + fr;
        if (u.pn < rope_units) {
            const int fi = 32 * (wc & 1) + 8 * fq;
            const int colb = u.pn * BM + 128 * (wc >> 1) + fi;
#pragma unroll
            for (int ai = 0; ai < 2; ++ai)
#pragma unroll
                for (int m = 0; m < 4; ++m) {
                    const int row = row0 + ai * HALF + m * 16;
                    const f32x4 c0 = *(const f32x4*)(cs + (size_t)row * 64 + fi), c1 = *(const f32x4*)(cs + (size_t)row * 64 + fi + 4);
                    const f32x4 s0 = *(const f32x4*)(sn + (size_t)row * 64 + fi), s1 = *(const f32x4*)(sn + (size_t)row * 64 + fi + 4);
                    const float rs = rstd ? rstd[row] : 1.0f;
                    const f32x4 x1a = acc[ai][0][m][0] * rs, x1b = acc[ai][0][m][1] * rs, x2a = acc[ai][1][m][0] * rs, x2b = acc[ai][1][m][1] * rs;
                    const f32x4 la = x1a * c0 - x2a * s0, lb = x1b * c1 - x2b * s1, ha = x2a * c0 + x1a * s0, hb = x2b * c1 + x1b * s1;
                    bf16_t* rowp = O + (size_t)row * ldc + colb;
                    *(u32x4*)(rowp) = pk8(la, lb); *(u32x4*)(rowp + 64) = pk8(ha, hb);
                }
        } else {
            const int col0 = u.pn * BM + wc * 32 + 8 * fq;
#pragma unroll
            for (int ai = 0; ai < 2; ++ai)
#pragma unroll
                for (int m = 0; m < 4; ++m) { const int row = row0 + ai * HALF + m * 16; bf16_t* rowp = O + (size_t)row * ldc + col0; const float rs = rstd ? rstd[row] : 1.0f;
#pragma unroll
                    for (int bj = 0; bj < 2; ++bj) *(u32x4*)(rowp + bj * HALF) = pk8(acc[ai][bj][m][0] * rs, acc[ai][bj][m][1] * rs); }
        }
    }
};

struct EpiY {
    static constexpr bool PERM = true, AFTER_DRAIN = false;
    bf16_t* C; int ldc; float* sumsq;
    __device__ __forceinline__ void operator()(const f32x4 (&acc)[2][2][4][2], const Unit& u, int wr, int wc, int fr, int fq) const {
        const int row0 = u.pm * BM + wr * 64 + fr, col0 = u.pn * BM + wc * 32 + 8 * fq;
#pragma unroll
        for (int ai = 0; ai < 2; ++ai)
#pragma unroll
            for (int m = 0; m < 4; ++m) { const int row = row0 + ai * HALF + m * 16; bf16_t* rowp = C + (size_t)row * ldc + col0; float ss = 0.f;
#pragma unroll
                for (int bj = 0; bj < 2; ++bj) { const f32x4 v0 = acc[ai][bj][m][0], v1 = acc[ai][bj][m][1];
                    *(u32x4*)(rowp + bj * HALF) = pk8(v0, v1);
                    ss += ((v0[0] * v0[0] + v0[1] * v0[1]) + (v0[2] * v0[2] + v0[3] * v0[3])) + ((v1[0] * v1[0] + v1[1] * v1[1]) + (v1[2] * v1[2] + v1[3] * v1[3])); }
                ss += __shfl_xor(ss, 16); ss += __shfl_xor(ss, 32);
                if (fq == 0) __hip_atomic_fetch_add(sumsq + row, ss, __ATOMIC_RELAXED, __HIP_MEMORY_SCOPE_AGENT); }
    }
};

struct EpiUp {
    static constexpr bool PERM = true, AFTER_DRAIN = false;
    bf16_t* act; const float* wconv; const float* bconv; float* first; float* last; const float* rstd;
    __device__ __forceinline__ void operator()(const f32x4 (&acc)[2][2][4][2], const Unit& u, int wr, int wc, int fr, int fq) const {
        constexpr int DFF = 5632;
        const int c0 = u.pn * HALF + wc * 32 + 8 * fq;
        float rsr[2][4];
#pragma unroll
        for (int ai = 0; ai < 2; ++ai)
#pragma unroll
            for (int m = 0; m < 4; ++m) rsr[ai][m] = rstd[u.pm * BM + ai * HALF + wr * 64 + m * 16 + fr];
#pragma unroll
        for (int n = 0; n < 2; ++n) {
            const f32x4 w0 = *(const f32x4*)(wconv + c0 + 4 * n), w1 = *(const f32x4*)(wconv + DFF + c0 + 4 * n), w2 = *(const f32x4*)(wconv + 2 * DFF + c0 + 4 * n), bc = *(const f32x4*)(bconv + c0 + 4 * n);
#pragma unroll
            for (int ai = 0; ai < 2; ++ai) {
                const int seg = u.pm * 4 + ai * 2 + wr;
                f32x4 o[4];
#pragma unroll
                for (int j = 0; j < 4; ++j) {
                    float g[4], p1[4], p2[4];
#pragma unroll
                    for (int m = 0; m < 4; ++m) { g[m] = acc[ai][0][m][n][j] * rsr[ai][m]; p1[m] = ror16<0x121>(g[m]); p2[m] = ror16<0x122>(g[m]); }
#pragma unroll
                    for (int m = 0; m < 4; ++m) {
                        const float pv1 = (fr >= 1) ? p1[m] : (m > 0 ? p1[m > 0 ? m - 1 : 0] : 0.f);
                        const float pv2 = (fr >= 2) ? p2[m] : (m > 0 ? p2[m > 0 ? m - 1 : 0] : 0.f);
                        const float a = bc[j] + w2[j] * g[m] + w1[j] * pv1 + w0[j] * pv2;
                        const float sg = __builtin_amdgcn_rcpf(1.0f + __builtin_amdgcn_exp2f(-1.44269504089f * a));
                        o[m][j] = a * sg * (acc[ai][1][m][n][j] * rsr[ai][m]);
                    }
                }
#pragma unroll
                for (int m = 0; m < 4; ++m) {
                    const int row = seg * 64 + m * 16 + fr;
                    if (m > 0 || fr >= 2) { u32x2 w; w.x = pk2(o[m][0], o[m][1]); w.y = pk2(o[m][2], o[m][3]); *(u32x2*)(act + (size_t)row * DFF + c0 + 4 * n) = w; }
                }
                if (fr < 2) {
                    float* fp = first + ((size_t)(seg * 2 + fr) * 2) * DFF + c0 + 4 * n;
                    *(f32x4*)(fp) = acc[ai][0][0][n] * rsr[ai][0]; *(f32x4*)(fp + DFF) = acc[ai][1][0][n] * rsr[ai][0];
                }
                if (fr >= 14) {
                    float* lp = last + (size_t)(seg * 2 + (fr - 14)) * DFF + c0 + 4 * n;
                    *(f32x4*)(lp) = acc[ai][0][3][n] * rsr[ai][3];
                }
            }
        }
    }
};
}

using pg8::bf16_t; using pg8::bf16x8; using pg8::f32x4; using pg8::u32x4;
#define LAS PG8_LAS
typedef float f32x16 __attribute__((ext_vector_type(16)));
typedef short s16x4 __attribute__((ext_vector_type(4)));
using pg8::u32x2;

constexpr int S_ = 16384, D_ = 2048, DFF_ = 5632, NMEM_ = 256;
constexpr float EPS_ = 1e-6f;
constexpr int LDS_BYTES = pg8::STAGE_BYTES + 1024;
constexpr int NPHASE = 16;
constexpr size_t SIDE_OFF = (size_t)16384 * 2048 / 2;

struct Params {
    const float *x, *mem, *norms, *w_in_a, *w_o_a, *g_kv, *w_kv, *w_in_b, *w_o_b, *w_mem_kv, *w_up, *w_conv, *b_conv, *w_down;
    float* out;
    bf16_t *BtA, *BtM, *BtOA, *BtUp0, *BtDn0, *BtB, *BtOB, *BtUp1, *BtDn1;
    float *cs, *sn;
    bf16_t *h, *hm, *mkv, *big, *heads;
    float *y, *lse, *sumsq, *rstd;
    unsigned* bar;
    long long coop;
};

enum { K_PREP = 0, K_GPROJ, K_ATTN, K_MERGE, K_GY, K_ROW, K_GUP, K_FIX };
constexpr unsigned long long pack_tab(const int* a, int n, int bits) { unsigned long long v = 0; for (int i = 0; i < n; ++i) v |= (unsigned long long)a[i] << (bits * i); return v; }
constexpr int PH_KINDS[NPHASE] = {K_PREP, K_GPROJ, K_ATTN, K_MERGE, K_GY, K_ROW, K_GUP, K_GY, K_ROW, K_GPROJ, K_ATTN, K_GY, K_ROW, K_GUP, K_GY, K_ROW};
constexpr int PH_VARS[NPHASE]  = {0,      0,       0,      0,       0,    0,     0,     1,    1,     2,       1,      2,    2,     1,     3,    3};
constexpr int PH_SYNCS[NPHASE] = {1,      1,       1,      1,       1,    1,     1,     1,    1,     1,       1,      1,    1,     1,     1,    0};
constexpr unsigned long long PK_KINDS = pack_tab(PH_KINDS, NPHASE, 3), PK_VARS = pack_tab(PH_VARS, NPHASE, 2), PK_SYNCS = pack_tab(PH_SYNCS, NPHASE, 1);
__host__ __device__ inline void phase_info(int ph, int& kind, int& var, int& sync_after) {
    kind = (int)((PK_KINDS >> (3 * ph)) & 7ull); var = (int)((PK_VARS >> (2 * ph)) & 3ull); sync_after = (int)((PK_SYNCS >> ph) & 1ull);
}

__device__ __forceinline__ float wave_sum(float v) {
#pragma unroll
    for (int o = 32; o >= 1; o >>= 1) v += __shfl_xor(v, o);
    return v;
}

struct WJob { const float* W; const float* gain; bf16_t* Bt; int K, N, map; };
__device__ __forceinline__ WJob wjob(const Params& p, int j) {
    WJob w; w.gain = nullptr; w.map = 0;
    switch (j) {
    case 0: w.W = p.w_in_a; w.gain = p.norms + 0 * D_; w.Bt = p.BtA; w.K = D_; w.N = 5120; w.map = 1; break;
    case 1: w.W = p.w_mem_kv; w.gain = p.norms + 4 * D_; w.Bt = p.BtM; w.K = D_; w.N = 1024; break;
    case 2: w.W = p.w_mem_kv + (size_t)D_ * 1024; w.gain = p.norms + 9 * D_; w.Bt = p.BtM + (size_t)1024 * D_; w.K = D_; w.N = 1024; break;
    case 3: w.W = p.w_o_a; w.Bt = p.BtOA; w.K = 1024; w.N = D_; break;
    case 4: w.W = p.w_up; w.gain = p.norms + 2 * D_; w.Bt = p.BtUp0; w.K = D_; w.N = 2 * DFF_; w.map = 2; break;
    case 5: w.W = p.w_down; w.Bt = p.BtDn0; w.K = DFF_; w.N = D_; break;
    case 6: w.W = p.w_kv; w.gain = p.g_kv; w.Bt = p.BtB; w.K = D_; w.N = 3072; break;
    case 7: w.W = p.w_in_b; w.gain = p.norms + 5 * D_; w.Bt = p.BtB + (size_t)3072 * D_; w.K = D_; w.N = D_; break;
    case 8: w.W = p.w_o_b; w.Bt = p.BtOB; w.K = D_; w.N = D_; break;
    case 9: w.W = p.w_up + (size_t)D_ * 2 * DFF_; w.gain = p.norms + 7 * D_; w.Bt = p.BtUp1; w.K = D_; w.N = 2 * DFF_; w.map = 2; break;
    default: w.W = p.w_down + (size_t)DFF_ * D_; w.Bt = p.BtDn1; w.K = DFF_; w.N = D_; break;
    }
    return w;
}
__device__ __forceinline__ int dest_chunk(int map, int ci) {
    if (map == 1) { if (ci < 48) { const int u = ci >> 2, w = ci & 3; return 4 * u + 2 * (w & 1) + (w >> 1); } return ci; }
    if (map == 2) { if (ci < 88) return 4 * (ci >> 1) + (ci & 1); const int c2 = ci - 88; return 4 * (c2 >> 1) + 2 + (c2 & 1); }
    return ci;
}

constexpr unsigned MEMKV_READY_WORD = 124;
constexpr unsigned MEMKV_PIECES = 256 + 256;
__device__ __forceinline__ void prep_phase(const Params& p, LAS unsigned char* lds, int wave_s) {
    const int tid = opaque_tid(wave_s), lane = tid & 63, wid = tid >> 6;
    const int bid = opaque_bid();
    const bool memblk = bid < 8;
    unsigned* ready = p.bar + MEMKV_READY_WORD;
    if (!memblk) {
        const int nb = (int)gridDim.x - 8, bi = bid - 8;
        {
            const int r1 = NMEM_ + S_, rstep = nb * 8;
            for (int rowa = bi * 8 + wid; rowa < r1; rowa += 2 * rstep) {
                const bool two = (rowa + rstep < r1);
                int rws[2]; rws[0] = rowa; rws[1] = two ? rowa + rstep : rowa;
                f32x4 v[2][8];
#pragma unroll
                for (int r = 0; r < 2; ++r) { const float* src = rws[r] < NMEM_ ? p.mem + (size_t)rws[r] * D_ : p.x + (size_t)(rws[r] - NMEM_) * D_;
#pragma unroll
                    for (int i = 0; i < 8; ++i) v[r][i] = *(const f32x4*)(src + 4 * (lane + 64 * i)); }
#pragma unroll
                for (int r = 0; r < 2; ++r) {
                    if (r == 1 && !two) break;
                    const int vr = rws[r]; const bool ismem = vr < NMEM_;
                    bf16_t* dst = ismem ? p.hm + (size_t)vr * D_ : p.h + (size_t)(vr - NMEM_) * D_;
                    float ss = 0.f;
#pragma unroll
                    for (int i = 0; i < 8; ++i) ss += (v[r][i][0] * v[r][i][0] + v[r][i][1] * v[r][i][1]) + (v[r][i][2] * v[r][i][2] + v[r][i][3] * v[r][i][3]);
                    ss = wave_sum(ss); const float rs = 1.0f / sqrtf(ss * (1.0f / D_) + EPS_);
                    const float sc = ismem ? rs : 1.0f;
                    if (!ismem && lane == 0) p.rstd[vr - NMEM_] = rs;
#pragma unroll
                    for (int i = 0; i < 8; ++i) { u32x2 w; w.x = pg8::pk2(v[r][i][0] * sc, v[r][i][1] * sc); w.y = pg8::pk2(v[r][i][2] * sc, v[r][i][3] * sc); *(u32x2*)(dst + 4 * (lane + 64 * i)) = w; }
                    if (ismem) {
                        asm volatile("s_waitcnt vmcnt(0)" ::: "memory"); __builtin_amdgcn_fence(__ATOMIC_RELEASE, "agent"); asm volatile("s_waitcnt vmcnt(0)" ::: "memory");
                        if (lane == 0) __hip_atomic_fetch_add(ready, 1u, __ATOMIC_RELAXED, __HIP_MEMORY_SCOPE_AGENT);
                    }
                }
            }
        }
        LAS float* T = (LAS float*)lds;
        constexpr int WT[11] = {640, 0, 0, 128, 1408, 704, 384, 256, 256, 1408, 704};
        constexpr int total = 6144;
        constexpr int TP = 260;
        const int kk0 = tid >> 6, c4 = (tid & 63) * 4;
        f32x4 v[8]; float gk[8];
        WJob w; int cg = 0, kt = 0;
        auto locate = [&](int t, WJob& wj, int& cgo, int& kto) {
            int j = 0, base = 0, accum = 256;
            if (t < 256) { j = 1 + (t >> 7); base = (t >> 7) << 7; }
            else {
#pragma unroll
                for (int q = 0; q < 11; ++q) { if (t >= accum) { j = q; base = accum; } accum += WT[q]; }
            }
            wj = wjob(p, j); const int lt = t - base, ncg = wj.N / 256; cgo = lt % ncg; kto = lt / ncg;
        };
        auto issue = [&](const WJob& wj, int cgi, int kti) {
#pragma unroll
            for (int i = 0; i < 8; ++i) { const int k = kti * 64 + kk0 + 8 * i; v[i] = *(const f32x4*)(wj.W + (size_t)k * wj.N + cgi * 256 + c4); gk[i] = wj.gain ? wj.gain[k] : 1.0f; }
        };
        int t = bi;
        if (t < total) { locate(t, w, cg, kt); issue(w, cg, kt); }
        while (t < total) {
#pragma unroll
            for (int i = 0; i < 8; ++i) *(LAS f32x4*)(T + (kk0 + 8 * i) * TP + c4) = v[i] * gk[i];
            __syncthreads();
            const WJob wc = w; const int cgc = cg, ktc = kt;
            const int tn = t + nb;
            if (tn < total) { locate(tn, w, cg, kt); issue(w, cg, kt); }
            {   const int c = tid & 255, half = tid >> 8; const int drow = dest_chunk(wc.map, cgc * 4 + (c >> 6)) * 64 + (c & 63);
                bf16_t* dst = wc.Bt + (size_t)drow * wc.K + ktc * 64 + half * 32;
#pragma unroll
                for (int q = 0; q < 4; ++q) { float f[8];
#pragma unroll
                    for (int i = 0; i < 8; ++i) f[i] = T[(half * 32 + q * 8 + i) * TP + c];
                    u32x4 o; o.x = pg8::pk2(f[0], f[1]); o.y = pg8::pk2(f[2], f[3]); o.z = pg8::pk2(f[4], f[5]); o.w = pg8::pk2(f[6], f[7]);
                    *(u32x4*)(dst + q * 8) = o; }
            }
            if (t < 256) asm volatile("s_waitcnt vmcnt(0)" ::: "memory");
            __syncthreads();
            if (t < 256 && tid == 0) {
                __builtin_amdgcn_fence(__ATOMIC_RELEASE, "agent"); asm volatile("s_waitcnt vmcnt(0)" ::: "memory");
                __hip_atomic_fetch_add(ready, 1u, __ATOMIC_RELAXED, __HIP_MEMORY_SCOPE_AGENT);
            }
            t = tn;
        }
        for (int i = bi * 512 + tid; i < 4 * S_; i += nb * 512) p.sumsq[i] = 0.f;
        for (int i = bi * 512 + tid; i < S_ * 64; i += nb * 512) {
            const int pos = i >> 6, f = i & 63;
            double dinv = 1.0; for (int q = 0; q < f; ++q) dinv *= 0.8659643233600653;
            const float inv = (float)dinv;
            const float ang = (float)pos * inv;
            const double tt = (double)ang * 0.15915494309189535; const float fr = (float)(tt - rint(tt));
            p.cs[i] = __builtin_amdgcn_cosf(fr); p.sn[i] = __builtin_amdgcn_sinf(fr);
        }
    } else {
        if (tid == 0) {
            unsigned spins = 0;
            while (__hip_atomic_load(ready, __ATOMIC_RELAXED, __HIP_MEMORY_SCOPE_AGENT) < MEMKV_PIECES) { __builtin_amdgcn_s_sleep(8); if (++spins > (1u << 22)) break; }
            __builtin_amdgcn_fence(__ATOMIC_ACQUIRE, "agent"); asm volatile("s_waitcnt vmcnt(0)" ::: "memory");
        }
        __syncthreads();
        pg8::Gemm g; g.A = p.hm; g.Bt = p.BtM; g.M = NMEM_; g.N = 2048; g.K = D_;
        pg8::EpiProj E; E.cs = p.cs; E.sn = p.sn; E.O = p.mkv; E.ldc = 2048; E.rope_units = 0; E.rstd = nullptr;
        pg8::StaticOrder S; S.init(g.M, g.N, 8, bid);
        pg8::gemm_phase<pg8::EpiProj, pg8::StaticOrder, false>(lds, g, S, E, nullptr, wave_s);
    }
}

template <bool XIN32, bool OUT32>
__device__ __forceinline__ void row_phase(const bf16_t* y, const float* sumsq, const float* g, const float* xin32, bf16_t* xh, float* out32, float* rstd_out, int wave_s) {
    const int tid = opaque_tid(wave_s), lane = tid & 63, wid = tid >> 6;
    f32x4 gv[8];
#pragma unroll
    for (int i = 0; i < 8; ++i) gv[i] = *(const f32x4*)(g + 4 * (lane + 64 * i));
    const int step = (int)gridDim.x * 8;
    for (int row0 = opaque_bid() * 8 + wid; row0 < S_; row0 += 2 * step) {
        int rows[2]; rows[0] = row0; rows[1] = (row0 + step < S_) ? row0 + step : row0;
        u32x2 yw[2][8]; f32x4 xf[2][8]; u32x2 xw[2][8]; float sq[2];
#pragma unroll
        for (int r = 0; r < 2; ++r) { sq[r] = sumsq[rows[r]];
#pragma unroll
            for (int i = 0; i < 8; ++i) { const size_t o = (size_t)rows[r] * D_ + 4 * (lane + 64 * i); yw[r][i] = *(const u32x2*)(y + o);
                if (XIN32) xf[r][i] = *(const f32x4*)(xin32 + o); else xw[r][i] = *(const u32x2*)(xh + o); } }
#pragma unroll
        for (int r = 0; r < 2; ++r) {
            const int row = rows[r];
            const float ry = 1.0f / sqrtf(sq[r] * (1.0f / D_) + EPS_);
            f32x4 v[8]; float ss = 0.f;
#pragma unroll
            for (int i = 0; i < 8; ++i) {
                f32x4 yy; yy[0] = __uint_as_float(yw[r][i].x << 16); yy[1] = __uint_as_float(yw[r][i].x & 0xffff0000u); yy[2] = __uint_as_float(yw[r][i].y << 16); yy[3] = __uint_as_float(yw[r][i].y & 0xffff0000u);
                f32x4 xx;
                if (XIN32) xx = xf[r][i];
                else { xx[0] = __uint_as_float(xw[r][i].x << 16); xx[1] = __uint_as_float(xw[r][i].x & 0xffff0000u); xx[2] = __uint_as_float(xw[r][i].y << 16); xx[3] = __uint_as_float(xw[r][i].y & 0xffff0000u); }
                v[i] = xx + yy * ry * gv[i]; ss += (v[i][0] * v[i][0] + v[i][1] * v[i][1]) + (v[i][2] * v[i][2] + v[i][3] * v[i][3]); }
            if (OUT32) {
#pragma unroll
                for (int i = 0; i < 8; ++i) *(f32x4*)(out32 + (size_t)row * D_ + 4 * (lane + 64 * i)) = v[i];
            } else {
#pragma unroll
                for (int i = 0; i < 8; ++i) { u32x2 w; w.x = pg8::pk2(v[i][0], v[i][1]); w.y = pg8::pk2(v[i][2], v[i][3]); *(u32x2*)(xh + (size_t)row * D_ + 4 * (lane + 64 * i)) = w; }
                ss = wave_sum(ss); if (lane == 0) rstd_out[row] = 1.0f / sqrtf(ss * (1.0f / D_) + EPS_);
            }
        }
    }
}

__device__ __forceinline__ void fix_phase(bf16_t* act, const float* wconv, const float* bconv, const float* first, const float* last, int seg_begin, int seg_end, int wave_s) {
    const int tid = opaque_tid(wave_s);
    for (int seg = seg_begin; seg < seg_end; ++seg) {
        const float* f0 = first + (size_t)(seg * 2) * 2 * DFF_; const float* f1 = f0 + 2 * DFF_;
        const float* lp = last + (size_t)((seg > 0 ? seg - 1 : 0) * 2) * DFF_;
        for (int c = tid * 4; c < DFF_; c += 512 * 4) {
            const f32x4 g0 = *(const f32x4*)(f0 + c), v0 = *(const f32x4*)(f0 + DFF_ + c), g1 = *(const f32x4*)(f1 + c), v1 = *(const f32x4*)(f1 + DFF_ + c);
            f32x4 gm2 = *(const f32x4*)(lp + c), gm1 = *(const f32x4*)(lp + DFF_ + c);
            if (seg == 0) { gm2 = (f32x4){0.f, 0.f, 0.f, 0.f}; gm1 = gm2; }
            const f32x4 w0 = *(const f32x4*)(wconv + c), w1 = *(const f32x4*)(wconv + DFF_ + c), w2 = *(const f32x4*)(wconv + 2 * DFF_ + c), bc = *(const f32x4*)(bconv + c);
            const f32x4 a0 = bc + w2 * g0 + w1 * gm1 + w0 * gm2, a1 = bc + w2 * g1 + w1 * g0 + w0 * gm1;
            f32x4 o0, o1;
#pragma unroll
            for (int j = 0; j < 4; ++j) { o0[j] = a0[j] * __builtin_amdgcn_rcpf(1.0f + __builtin_amdgcn_exp2f(-1.44269504089f * a0[j])) * v0[j];
                                          o1[j] = a1[j] * __builtin_amdgcn_rcpf(1.0f + __builtin_amdgcn_exp2f(-1.44269504089f * a1[j])) * v1[j]; }
            u32x2 w; w.x = pg8::pk2(o0[0], o0[1]); w.y = pg8::pk2(o0[2], o0[3]); *(u32x2*)(act + (size_t)(seg * 64) * DFF_ + c) = w;
            w.x = pg8::pk2(o1[0], o1[1]); w.y = pg8::pk2(o1[2], o1[3]); *(u32x2*)(act + (size_t)(seg * 64 + 1) * DFF_ + c) = w;
        }
    }
}

__device__ __forceinline__ void merge_phase(const bf16_t* og, const float* lse, bf16_t* heads, int wave_s) {
    const int tid = opaque_tid(wave_s);
    const int gs = (int)gridDim.x * 512;
    for (int i0 = opaque_bid() * 512 + tid; i0 < S_ * 64; i0 += 2 * gs) {
        int idx[2]; idx[0] = i0; idx[1] = (i0 + gs < S_ * 64) ? i0 + gs : i0;
        float l[2][3]; u32x4 a[2][3];
#pragma unroll
        for (int r = 0; r < 2; ++r) { const int pos = idx[r] >> 6, c = (idx[r] & 63) * 8, hh = c >> 7;
#pragma unroll
            for (int gq = 0; gq < 3; ++gq) { l[r][gq] = lse[(size_t)(gq * S_ + pos) * 4 + hh]; a[r][gq] = *(const u32x4*)(og + (size_t)(gq * S_ + pos) * 512 + c); } }
#pragma unroll
        for (int r = 0; r < 2; ++r) { const int pos = idx[r] >> 6, c = (idx[r] & 63) * 8;
            const float mx = fmaxf(l[r][0], fmaxf(l[r][1], l[r][2]));
            float e0 = __builtin_amdgcn_exp2f(l[r][0] - mx), e1 = __builtin_amdgcn_exp2f(l[r][1] - mx), e2 = __builtin_amdgcn_exp2f(l[r][2] - mx);
            const float inv = 1.0f / (e0 + e1 + e2); e0 *= inv; e1 *= inv; e2 *= inv;
            u32x4 w;
#pragma unroll
            for (int q = 0; q < 4; ++q) {
                const unsigned w0 = a[r][0][q], w1 = a[r][1][q], w2 = a[r][2][q];
                const float lo = __uint_as_float(w0 << 16) * e0 + __uint_as_float(w1 << 16) * e1 + __uint_as_float(w2 << 16) * e2;
                const float hi = __uint_as_float(w0 & 0xffff0000u) * e0 + __uint_as_float(w1 & 0xffff0000u) * e1 + __uint_as_float(w2 & 0xffff0000u) * e2;
                w[q] = pg8::pk2(lo, hi); }
            *(u32x4*)(heads + (size_t)pos * 1024 + c) = w; }
    }
}

struct AttnItem {
    const bf16_t* q; const bf16_t* k; const bf16_t* v; long qp, kp;
    int mode;
    int t0, t1, tstep;
    int nb0;
    bf16_t* ob; long obp; bf16_t* of; long ofp; float* ol; long olp;
};
__device__ __forceinline__ unsigned offb(unsigned row, unsigned ch) { return 256u * row + 16u * (ch ^ (((row & 3u) << 2) | ((row >> 2) & 3u))); }

__device__ __forceinline__ void attn_stage(LAS unsigned char* lds, unsigned bufoff, const bf16_t* base, long pitch, int tile, int tid, int wid) {
#pragma unroll
    for (int i = 0; i < 4; ++i) {
        const unsigned row = i * 32 + (tid >> 4), pch = tid & 15, ch = pch ^ (((row & 3u) << 2) | ((row >> 2) & 3u));
        const bf16_t* g = base + (size_t)(tile * 128 + (int)row) * pitch + ch * 8;
        __builtin_amdgcn_global_load_lds((const unsigned*)g, (LAS unsigned*)(lds + bufoff + i * 8192 + wid * 1024), 16, 0, 0);
    }
}

template <int MODE> __device__ __forceinline__ void attn_item(const AttnItem& it, LAS unsigned char* lds, int wave_s) {
    const int tid = opaque_tid(wave_s), wid = __builtin_amdgcn_readfirstlane(tid >> 6), lane = tid & 63, r = lane & 31, h = lane >> 5;
    constexpr unsigned KB0 = 0, VB0 = 65536;
    LAS unsigned* flags = (LAS unsigned*)(lds + pg8::STAGE_BYTES);
    const float sc2 = 0.08838834764831845f * 1.4426950408889634f;
    const int myblk = it.nb0 + (wid >> 2);
    const int nq = myblk * 128 + (wid & 3) * 32 + r;
    bf16x8 qf[8];
    { const bf16_t* qrow = it.q + (size_t)(wid * 32 + r) * it.qp + 8 * h;
#pragma unroll
      for (int s = 0; s < 8; ++s) qf[s] = *(const bf16x8*)(qrow + 16 * s); }
    f32x16 o[4];
#pragma unroll
    for (int d = 0; d < 4; ++d)
#pragma unroll
        for (int i = 0; i < 16; ++i) o[d][i] = 0.f;
    float mrun = -1e30f, lrun = 0.f, carry = 1.0f;
    const unsigned sw = ((r & 3u) << 2) | ((r >> 2) & 3u);
    const unsigned q4 = (lane & 15) >> 2, p4 = lane & 3, blk = (lane >> 4) & 1;
    const unsigned kbase = 256u * r + 16u * (h ^ (sw & 1u)), b3 = (sw >> 1) & 7u;
    const unsigned xv = 2u * blk + (p4 >> 1);
    const unsigned vlob = 256u * (4u * h + q4) + 16u * (xv ^ h) + 8u * (p4 & 1u), vhib = 256u * (4u * h + q4 + 8u) + 16u * (xv ^ (h + 2u)) + 8u * (p4 & 1u);

    int t = it.t0, cur = 0;
    attn_stage(lds, KB0, it.k, it.kp, t, tid, wid); attn_stage(lds, VB0, it.v, it.kp, t, tid, wid);
    asm volatile("s_waitcnt vmcnt(0)" ::: "memory"); __builtin_amdgcn_s_barrier(); asm volatile("" ::: "memory");
    for (;;) {
        const bool has_next = (t != it.t1);
        if (has_next) { attn_stage(lds, KB0 + (cur ^ 1) * 32768, it.k, it.kp, t + it.tstep, tid, wid); attn_stage(lds, VB0 + (cur ^ 1) * 32768, it.v, it.kp, t + it.tstep, tid, wid); }
        const unsigned kbuf = KB0 + cur * 32768, vbuf = VB0 + cur * 32768;
        bool relevant;
        if (MODE == 0) relevant = true; else if (MODE == 1) relevant = (t == myblk || t == myblk - 1);
        else relevant = (t <= myblk) && (__ballot(carry != 0.0f) != 0ull);
        if (relevant) {
            const bool diag = (t == myblk);
            const int iq = (wid & 3) * 32 + r, wq = wid & 3;
            auto need = [&](int kb) -> bool {
                if (MODE == 1) return (t == myblk) ? (kb <= wq) : (kb >= wq);
                if (MODE == 2) return !diag || kb <= wq;
                return true; };
            auto comp_s = [&](int kb, f32x16& sv) {
                unsigned bb = b3; asm volatile("" : "+v"(bb));
                bf16x8 kf[8];
#pragma unroll
                for (int ks = 0; ks < 8; ++ks) kf[ks] = *(const LAS bf16x8*)(lds + kbuf + kbase + 32u * ((unsigned)ks ^ bb) + kb * 8192);
                __builtin_amdgcn_sched_barrier(0);
#pragma unroll
                for (int i = 0; i < 16; ++i) sv[i] = 0.f;
#pragma unroll
                for (int ks = 0; ks < 8; ++ks) sv = __builtin_amdgcn_mfma_f32_32x32x16_bf16(kf[ks], qf[ks], sv, 0, 0, 0);
                __builtin_amdgcn_sched_barrier(0);
            };
            auto proc_pv = [&](int kb, f32x16& sv) {
                unsigned qq = q4; asm volatile("" : "+v"(qq));
                if (MODE != 2) {
                    float mx = -1e30f;
#pragma unroll
                    for (int i = 0; i < 16; ++i) {
                        float xv = sv[i] * sc2;
                        if (MODE == 1) { const int m = t * 128 + kb * 32 + (i & 3) + 8 * (i >> 2) + 4 * h; const int rel = nq - m; if (rel < 0 || rel > 128) xv = -1e30f; }
                        sv[i] = xv; mx = fmaxf(mx, xv);
                    }
                    mx = fmaxf(mx, __shfl_xor(mx, 32));
                    const float mnew = fmaxf(mrun, mx), alpha = __builtin_amdgcn_exp2f(mrun - mnew);
                    float ls = 0.f;
#pragma unroll
                    for (int i = 0; i < 16; ++i) { const float pv = (sv[i] > -1e29f) ? __builtin_amdgcn_exp2f(sv[i] - mnew) : 0.f; sv[i] = pv; ls += pv; }
                    ls += __shfl_xor(ls, 32);
                    lrun = lrun * alpha + ls; mrun = mnew;
                    if (__ballot(alpha != 1.0f) != 0ull) {
#pragma unroll
                        for (int d = 0; d < 4; ++d)
#pragma unroll
                            for (int i = 0; i < 16; ++i) o[d][i] *= alpha;
                    }
                } else {
                    float G[4], GP[4];
#pragma unroll
                    for (int i = 0; i < 16; ++i) {
                        const float e = __builtin_amdgcn_exp2f(sv[i] * sc2);
                        float kp = __builtin_amdgcn_rcpf(1.0f + e);
                        if (diag) { const int kl = kb * 32 + (i & 3) + 8 * (i >> 2) + 4 * h; if (kl >= iq) kp = 1.0f; }
                        sv[i] = kp;
                    }
#pragma unroll
                    for (int g = 0; g < 4; ++g) { G[g] = (sv[4 * g] * sv[4 * g + 1]) * (sv[4 * g + 2] * sv[4 * g + 3]); GP[g] = __shfl_xor(G[g], 32); }
                    float R = carry;
#pragma unroll
                    for (int g = 3; g >= 0; --g) {
                        float w = (h == 0) ? R * GP[g] : R;
                        R *= G[g] * GP[g];
#pragma unroll
                        for (int j = 3; j >= 0; --j) { const float kp = sv[4 * g + j]; sv[4 * g + j] = (1.0f - kp) * w; w *= kp; }
                    }
                    carry = R;
                }
#pragma unroll
                for (int s2 = 0; s2 < 2; ++s2) {
                    u32x4 pw; pw.x = pg8::pk2(sv[8 * s2 + 0], sv[8 * s2 + 1]); pw.y = pg8::pk2(sv[8 * s2 + 2], sv[8 * s2 + 3]);
                    pw.z = pg8::pk2(sv[8 * s2 + 4], sv[8 * s2 + 5]); pw.w = pg8::pk2(sv[8 * s2 + 6], sv[8 * s2 + 7]);
                    const bf16x8 pf = __builtin_bit_cast(bf16x8, pw);
                    s16x4 lo[4], hi[4];
#pragma unroll
                    for (int d = 0; d < 4; ++d) {
                        lo[d] = __builtin_amdgcn_ds_read_tr16_b64_v4i16((LAS s16x4*)(lds + vbuf + vlob + 64u * ((unsigned)d ^ qq) + kb * 8192 + s2 * 4096));
                        hi[d] = __builtin_amdgcn_ds_read_tr16_b64_v4i16((LAS s16x4*)(lds + vbuf + vhib + 64u * ((unsigned)d ^ qq) + kb * 8192 + s2 * 4096));
                    }
                    __builtin_amdgcn_sched_barrier(0);
#pragma unroll
                    for (int d = 0; d < 4; ++d) {
                        const bf16x8 vf = __builtin_shufflevector(lo[d], hi[d], 0, 1, 2, 3, 4, 5, 6, 7);
                        o[d] = __builtin_amdgcn_mfma_f32_32x32x16_bf16(vf, pf, o[d], 0, 0, 0);
                    }
                    __builtin_amdgcn_sched_barrier(0);
                }
            };
            f32x16 sa, sb;
            const bool n3 = need(3), n2 = need(2), n1 = need(1), n0 = need(0);
            auto alive = [&]() -> bool { return MODE != 2 || __ballot(carry != 0.0f) != 0ull; };
            if (n3) comp_s(3, sa);
            if (n2) comp_s(2, sb);
            if (n3) proc_pv(3, sa);
            bool al = alive();
            if (n1 && al) comp_s(1, sa);
            if (n2 && al) proc_pv(2, sb);
            al = al && alive();
            if (n0 && al) comp_s(0, sb);
            if (n1 && al) proc_pv(1, sa);
            al = al && alive();
            if (n0 && al) proc_pv(0, sb);
        }
        if (MODE == 2) { const unsigned long long bal = __ballot(carry != 0.0f); if (lane == 0) flags[(t & 1) * 8 + wid] = (bal != 0ull) ? 1u : 0u; }
        asm volatile("s_waitcnt vmcnt(0) lgkmcnt(0)" ::: "memory"); __builtin_amdgcn_s_barrier(); asm volatile("" ::: "memory");
        if (!has_next) break;
        if (MODE == 2) { unsigned any = 0;
#pragma unroll
            for (int w = 0; w < 8; ++w) any |= flags[(t & 1) * 8 + w];
            if (__builtin_amdgcn_readfirstlane(any) == 0u) break; }
        t += it.tstep; cur ^= 1;
    }
    const int qi = wid * 32 + r;
    if (MODE == 1) {
        const float inv = 1.0f / lrun;
        bf16_t* orow = it.of + (size_t)qi * it.ofp;
#pragma unroll
        for (int d = 0; d < 4; ++d)
#pragma unroll
            for (int g = 0; g < 4; ++g) { u32x2 w; w.x = pg8::pk2(o[d][4 * g] * inv, o[d][4 * g + 1] * inv); w.y = pg8::pk2(o[d][4 * g + 2] * inv, o[d][4 * g + 3] * inv);
                *(u32x2*)(orow + 32 * d + 8 * g + 4 * h) = w; }
        if (h == 0) it.ol[(size_t)qi * it.olp] = mrun + __builtin_amdgcn_logf(lrun);
    } else {
        const float inv = (MODE == 0) ? 1.0f / lrun : 1.0f;
        bf16_t* orow = it.ob + (size_t)qi * it.obp;
#pragma unroll
        for (int d = 0; d < 4; ++d)
#pragma unroll
            for (int g = 0; g < 4; ++g) { u32x2 w; w.x = pg8::pk2(o[d][4 * g] * inv, o[d][4 * g + 1] * inv); w.y = pg8::pk2(o[d][4 * g + 2] * inv, o[d][4 * g + 3] * inv);
                *(u32x2*)(orow + 32 * d + 8 * g + 4 * h) = w; }
    }
}

__device__ __forceinline__ void attn_phase(const Params& p, int layer, LAS unsigned char* lds, int wave_s) {
    const int nitems = 768 + 256;
    for (int item = opaque_bid(); item < nitems; item += gridDim.x) {
        AttnItem it;
        it.ob = nullptr; it.obp = 0; it.of = nullptr; it.ofp = 0; it.ol = nullptr; it.olp = 0; it.tstep = 1; it.nb0 = 0;
        if (item >= 768) {
            const int mi = item - 768, hm = mi & 3, qb = mi >> 2;
            it.mode = 0; it.t0 = 0; it.t1 = 1;
            it.q = p.big + (size_t)(qb * 256) * 5120 + 4608 + hm * 128; it.qp = 5120;
            it.k = p.mkv + layer * 1024 + hm * 128; it.v = it.k + 512; it.kp = 2048;
            if (layer == 0) { it.ob = p.heads + (size_t)(qb * 256) * 1024 + 512 + hm * 128; it.obp = 1024; }
            else { it.ob = p.heads + (size_t)(qb * 256) * 2048 + 1536 + hm * 128; it.obp = 2048; }
        } else if (layer == 0) {
            const int g = item >> 8, li = item & 255, hh = li & 3, rest = li >> 2;
            const int dl = (g == 0) ? 1 : (g == 1 ? 4 : 16), npair = 64 / dl, rs = rest / npair, pr = rest % npair;
            const int hd = g * 4 + hh;
            it.mode = 1; it.nb0 = 2 * pr; it.t0 = (pr == 0) ? 0 : 2 * pr - 1; it.t1 = 2 * pr + 1;
            const size_t prow = (size_t)(pr * 256) * dl + rs;
            it.q = p.big + prow * 5120 + hd * 128; it.qp = (long)dl * 5120;
            it.k = p.big + (size_t)rs * 5120 + 1536 + hd * 128; it.v = it.k + 1536; it.kp = (long)dl * 5120;
            it.of = (bf16_t*)p.y + (size_t)g * S_ * 512 + prow * 512 + hh * 128; it.ofp = (long)dl * 512;
            it.ol = p.lse + (size_t)g * S_ * 4 + prow * 4 + hh; it.olp = (long)dl * 4;
        } else {
            const int hd = item % 12, qb = item / 12;
            it.mode = 2; it.nb0 = 2 * qb; it.t0 = 2 * qb + 1; it.t1 = 0; it.tstep = -1;
            it.q = p.big + (size_t)(qb * 256) * 5120 + 3072 + hd * 128; it.qp = 5120;
            it.k = p.big + hd * 128; it.v = it.k + 1536; it.kp = 5120;
            it.ob = p.heads + (size_t)(qb * 256) * 2048 + hd * 128; it.obp = 2048;
        }
        if (it.mode == 0) attn_item<0>(it, lds, wave_s); else if (it.mode == 1) attn_item<1>(it, lds, wave_s); else attn_item<2>(it, lds, wave_s);
    }
}

#define XB_TMO      128
#define XB_XCNT(j)  (256  + 64 * (j))
#define XB_XSUB(j)  (1280 + 64 * (j))
#define XB_XGEN(j)  (2304 + 64 * (j))
#define XB_TOP      3328
#define XB_TOPGEN   3392
#define XCD_BAR_WORDS 3456
#define XB_SPIN_CAP (1u << 18)

__device__ __forceinline__ unsigned xb_ld(unsigned* p)              { return __hip_atomic_load(p, __ATOMIC_RELAXED, __HIP_MEMORY_SCOPE_AGENT); }
__device__ __forceinline__ unsigned xb_add(unsigned* p, unsigned v) { return __hip_atomic_fetch_add(p, v, __ATOMIC_RELAXED, __HIP_MEMORY_SCOPE_AGENT); }
__device__ __forceinline__ unsigned xb_xcc_id() { return (unsigned)__builtin_amdgcn_s_getreg((3 << 11) | 20) & 0xFu; }
#define XB_SPIN(cond, bar) do { unsigned _sp = 0; while (cond) { __builtin_amdgcn_s_sleep(1); \
    if ((++_sp & 255u) == 0u) { if (xb_ld(&(bar)[XB_TMO])) break; if (_sp > XB_SPIN_CAP) { atomicAdd(&(bar)[XB_TMO], 1u); break; } } } } while (0)

struct XcdBarrier {
    unsigned* bar; unsigned x;
    volatile LAS unsigned* st;
};

__device__ __forceinline__ XcdBarrier xcd_barrier_post(unsigned* bar, volatile LAS unsigned* st, int tid) {
    XcdBarrier b; b.bar = bar; b.x = xb_xcc_id(); b.st = st;
    if (tid == 0) (void)xb_add(&bar[XB_XCNT(b.x)], 1u);
    return b;
}
__device__ __forceinline__ void xcd_barrier_complete(unsigned* bar, unsigned x, unsigned& nloc, unsigned& nx) {
    const unsigned G = gridDim.x * gridDim.y * gridDim.z;
    unsigned sum, cnt, mine, sp = 0u;
    for (;;) {
        sum = 0u; cnt = 0u; mine = 0u;
#pragma unroll
        for (unsigned j = 0; j < 16; ++j) { const unsigned c = xb_ld(&bar[XB_XCNT(j)]); sum += c; cnt += (c > 0u) ? 1u : 0u; mine = (j == x) ? c : mine; }
        if (sum == G) break;
        __builtin_amdgcn_s_sleep(1);
        if ((++sp & 255u) == 0u) { if (xb_ld(&bar[XB_TMO])) break; if (sp > XB_SPIN_CAP) { atomicAdd(&bar[XB_TMO], 1u); break; } }
    }
    nloc = mine > 0u ? mine : 1u; nx = cnt > 0u ? cnt : 1u;
}

__device__ __forceinline__ void xcd_barrier(const XcdBarrier& b, int tid) {
    asm volatile("s_waitcnt vmcnt(0)" ::: "memory");
    __syncthreads();
    if (tid == 0) {
        unsigned* bar = b.bar;
        __builtin_amdgcn_s_waitcnt(0);
        unsigned nloc = b.st[0], nx = b.st[1];
        if (nloc == 0u) { xcd_barrier_complete(bar, b.x, nloc, nx); b.st[0] = nloc; b.st[1] = nx; }
        const unsigned old = xb_add(&bar[XB_XSUB(b.x)], 1u);
        const unsigned gen = old / nloc;
        if (old + 1u == (gen + 1u) * nloc) {
            __builtin_amdgcn_fence(__ATOMIC_RELEASE, "agent");
            asm volatile("s_waitcnt vmcnt(0)" ::: "memory");
            const unsigned og = xb_add(&bar[XB_TOP], 1u);
            const unsigned tg = og / nx;
            if (og + 1u == (tg + 1u) * nx) xb_add(&bar[XB_TOPGEN], 1u);
            else XB_SPIN(xb_ld(&bar[XB_TOPGEN]) == tg, bar);
            __builtin_amdgcn_fence(__ATOMIC_ACQUIRE, "agent");
            xb_add(&bar[XB_XGEN(b.x)], 1u);
            asm volatile("s_waitcnt vmcnt(0)" ::: "memory");
        } else {
            XB_SPIN(xb_ld(&bar[XB_XGEN(b.x)]) == gen, bar);
            __builtin_amdgcn_fence(__ATOMIC_ACQUIRE, "agent");
            asm volatile("s_waitcnt vmcnt(0)" ::: "memory");
        }
    }
    __syncthreads();
}

__global__ __launch_bounds__(512, 2) void yoco_forward(Params p, int ph0, int ph1) {
    extern __shared__ __attribute__((aligned(16))) unsigned char shm[];
    LAS unsigned char* lds = (LAS unsigned char*)shm;
    const int wave_s = __builtin_amdgcn_readfirstlane((int)(threadIdx.x >> 6));
    volatile LAS unsigned* xbst = (volatile LAS unsigned*)(lds + pg8::STAGE_BYTES + 256);
    XcdBarrier xb; xb.bar = p.bar; xb.x = 0; xb.st = xbst;
    if (p.coop == 1) {
        const int t0 = opaque_tid(wave_s);
        if (t0 == 0) { xbst[0] = 0u; xbst[1] = 0u; xbst[2] = 0u; xbst[3] = 0u; }
        __syncthreads();
        xb = xcd_barrier_post(p.bar, xbst, t0);
        if (t0 == 0) xbst[2] = xb_add(&p.bar[8u * xb.x], 1u);
    }
    int unit_c = (int)blockIdx.x;
    for (int ph = ph0; ph < ph1; ++ph) {
        int kind, var, sync_after; phase_info(ph, kind, var, sync_after);
#ifndef ONLY_KIND
#define EN(k) true
#else
#define EN(k) ((k) == ONLY_KIND)
#endif
        if (kind == K_PREP && EN(K_PREP)) {
            prep_phase(p, lds, wave_s);
        } else if (kind == K_GPROJ && EN(K_GPROJ)) {
            pg8::Gemm g; pg8::EpiProj E; E.cs = p.cs; E.sn = p.sn;
            E.rstd = p.rstd; g.A = p.h; g.M = S_; g.N = 5120; g.K = D_; E.O = p.big; E.ldc = 5120;
            if (var == 0) { g.Bt = p.BtA; E.rope_units = 12; } else { g.Bt = p.BtB; E.rope_units = 0; }
            pg8::StaticOrder S; S.init(g.M, g.N, (int)gridDim.x, unit_c);
            pg8::gemm_phase<pg8::EpiProj, pg8::StaticOrder, false>(lds, g, S, E, nullptr, wave_s);
        } else if (kind == K_ATTN && EN(K_ATTN)) {
            attn_phase(p, var, lds, wave_s);
        } else if (kind == K_MERGE && EN(K_MERGE)) {
            merge_phase((const bf16_t*)p.y, p.lse, p.heads, wave_s);
        } else if (kind == K_GY && EN(K_GY)) {
            pg8::Gemm g; pg8::EpiY E; E.C = (bf16_t*)p.y; E.ldc = D_; E.sumsq = p.sumsq + var * S_; g.M = S_; g.N = D_;
            if (var == 0) { g.A = p.heads; g.Bt = p.BtOA; g.K = 1024; }
            else if (var == 1) { g.A = p.big; g.Bt = p.BtDn0; g.K = DFF_; }
            else if (var == 2) { g.A = p.heads; g.Bt = p.BtOB; g.K = D_; }
            else { g.A = p.big; g.Bt = p.BtDn1; g.K = DFF_; }
            pg8::StaticOrder S; S.init(g.M, g.N, (int)gridDim.x, unit_c);
            if (var == 1 || var == 3) {
                const int layer = var >> 1; pg8::Unit uu; int last_pm = -1;
                for (int i = 0; S.next(i, uu); ++i) if (uu.pm != last_pm) { last_pm = uu.pm;
                    fix_phase(p.big, p.w_conv + (size_t)layer * 3 * DFF_, p.b_conv + (size_t)layer * DFF_, p.y + SIDE_OFF, p.y + SIDE_OFF + (size_t)256 * 4 * DFF_, 4 * uu.pm, 4 * uu.pm + 4, wave_s); }
                asm volatile("s_waitcnt vmcnt(0)" ::: "memory"); __syncthreads();
            }
            pg8::gemm_phase<pg8::EpiY, pg8::StaticOrder, false>(lds, g, S, E, nullptr, wave_s);
        } else if (kind == K_ROW && EN(K_ROW)) {
            const int layer = var >> 1, which = var & 1;
            const float* gn = p.norms + (size_t)(layer * 5 + (which ? 3 : 1)) * D_;
            if (var == 0) row_phase<true, false>((const bf16_t*)p.y, p.sumsq, gn, p.x, p.h, nullptr, p.rstd, wave_s);
            else if (var == 3) row_phase<false, true>((const bf16_t*)p.y, p.sumsq + 3 * S_, gn, nullptr, p.h, p.out, p.rstd, wave_s);
            else row_phase<false, false>((const bf16_t*)p.y, p.sumsq + var * S_, gn, nullptr, p.h, nullptr, p.rstd, wave_s);
        } else if (kind == K_GUP && EN(K_GUP)) {
            pg8::Gemm g; g.A = p.h; g.Bt = var ? p.BtUp1 : p.BtUp0; g.M = S_; g.N = 2 * DFF_; g.K = D_;
            pg8::EpiUp E; E.act = p.big; E.wconv = p.w_conv + (size_t)var * 3 * DFF_; E.bconv = p.b_conv + (size_t)var * DFF_; E.first = p.y + SIDE_OFF; E.last = p.y + SIDE_OFF + (size_t)256 * 4 * DFF_; E.rstd = p.rstd;
            pg8::StaticOrder S; S.init(g.M, g.N, (int)gridDim.x, unit_c);
            pg8::gemm_phase<pg8::EpiUp, pg8::StaticOrder, false>(lds, g, S, E, nullptr, wave_s);
        }
        if (sync_after && ph + 1 < ph1) {
            if (p.coop == 1) xcd_barrier(xb, opaque_tid(wave_s));
            if (p.coop == 1 && ph == 0) {
                bool ok = (gridDim.x % 8u) == 0u;
                for (unsigned j = 0; j < 16; ++j) { const unsigned cnt = xb_ld(&p.bar[8u * j]); ok = ok && (cnt == (j < 8u ? gridDim.x / 8u : 0u)); }
                if (ok) unit_c = (int)(xbst[2] * 8u + xb.x);
            }
            else if (p.coop == 2) cooperative_groups::this_grid().sync();
        }
    }
}

#ifndef MK_LAUNCHES
#define MK_LAUNCHES 0
#endif

extern "C" void kernel_launch(void* const* d_in, const int* in_sizes, int n_in, void* d_out, int out_size, void* d_ws, size_t ws_size, hipStream_t stream) {
    (void)in_sizes; (void)n_in; (void)out_size;
    Params p{};
    p.x = (const float*)d_in[0]; p.mem = (const float*)d_in[1]; p.norms = (const float*)d_in[2]; p.w_in_a = (const float*)d_in[3]; p.w_o_a = (const float*)d_in[4];
    p.g_kv = (const float*)d_in[5]; p.w_kv = (const float*)d_in[6]; p.w_in_b = (const float*)d_in[7]; p.w_o_b = (const float*)d_in[8]; p.w_mem_kv = (const float*)d_in[9];
    p.w_up = (const float*)d_in[10]; p.w_conv = (const float*)d_in[11]; p.b_conv = (const float*)d_in[12]; p.w_down = (const float*)d_in[13];
    p.out = (float*)d_out;
    unsigned char* w = (unsigned char*)d_ws; size_t off = 0;
    auto take = [&](size_t bytes) { unsigned char* r = w + off; off += (bytes + 255) & ~(size_t)255; return r; };
    p.BtA = (bf16_t*)take((size_t)5120 * D_ * 2); p.BtM = (bf16_t*)take((size_t)2048 * D_ * 2); p.BtOA = (bf16_t*)take((size_t)D_ * 1024 * 2);
    p.BtUp0 = (bf16_t*)take((size_t)2 * DFF_ * D_ * 2); p.BtDn0 = (bf16_t*)take((size_t)D_ * DFF_ * 2); p.BtB = (bf16_t*)take((size_t)5120 * D_ * 2);
    p.BtOB = (bf16_t*)take((size_t)D_ * D_ * 2); p.BtUp1 = (bf16_t*)take((size_t)2 * DFF_ * D_ * 2); p.BtDn1 = (bf16_t*)take((size_t)D_ * DFF_ * 2);
    p.cs = (float*)take((size_t)S_ * 64 * 4); p.sn = (float*)take((size_t)S_ * 64 * 4);
    p.h = (bf16_t*)take((size_t)S_ * D_ * 2); p.hm = (bf16_t*)take((size_t)NMEM_ * D_ * 2); p.mkv = (bf16_t*)take((size_t)NMEM_ * 2048 * 2);
    p.big = (bf16_t*)take((size_t)S_ * DFF_ * 2); p.heads = (bf16_t*)take((size_t)S_ * D_ * 2);
    p.y = (float*)take((size_t)S_ * D_ * 4); p.lse = (float*)take((size_t)3 * S_ * 4 * 4); p.sumsq = (float*)take((size_t)4 * S_ * 4);
    p.rstd = (float*)take((size_t)S_ * 4);
    p.bar = (unsigned*)take((size_t)XCD_BAR_WORDS * 4);
    if (off > ws_size) { fprintf(stderr, "workspace too small: need %zu have %zu\n", off, ws_size); return; }
    static int grid_blocks = 0;
    if (!grid_blocks) {
        int dev = 0, cus = 0, per_cu = 0;
        hipGetDevice(&dev); hipDeviceGetAttribute(&cus, hipDeviceAttributeMultiprocessorCount, dev);
        hipFuncSetAttribute((const void*)yoco_forward, hipFuncAttributeMaxDynamicSharedMemorySize, LDS_BYTES);
        hipOccupancyMaxActiveBlocksPerMultiprocessor(&per_cu, yoco_forward, 512, LDS_BYTES);
        if (per_cu < 1) per_cu = 1;
        grid_blocks = cus * per_cu;
    }
    hipMemsetAsync(p.bar, 0, (size_t)XCD_BAR_WORDS * 4, stream);
#if MK_LAUNCHES
    p.coop = 0;
    int ph = 0;
    while (ph < NPHASE) {
        int e = ph; for (;;) { int kind, var, sy; phase_info(e, kind, var, sy); ++e; if (sy || e >= NPHASE) break; }
        hipLaunchKernelGGL(yoco_forward, dim3(grid_blocks), dim3(512), LDS_BYTES, stream, p, ph, e);
        ph = e;
    }
#else
    p.coop = 1;
    int ph0 = 0, ph1 = NPHASE;
    void* args[] = {&p, &ph0, &ph1};
    hipError_t e = hipLaunchCooperativeKernel((const void*)yoco_forward, dim3(grid_blocks), dim3(512), args, LDS_BYTES, stream);
    if (e != hipSuccess) fprintf(stderr, "cooperative launch failed: %s (grid %d)\n", hipGetErrorString(e), grid_blocks);
#endif
}
```

```cpp
#include <hip/hip_runtime.h>
#include <hip/hip_cooperative_groups.h>
#include <cstdio>
__device__ __forceinline__ int opaque_tid(int wave_s) { unsigned m = ~0u; asm volatile("" : "+s"(m)); int w = wave_s; asm volatile("" : "+s"(w));
    int t = w * 64 + (int)__builtin_amdgcn_mbcnt_hi(m, __builtin_amdgcn_mbcnt_lo(m, 0u)); asm volatile("" : "+v"(t)); return t; }
__device__ __forceinline__ int opaque_bid() { int b = (int)blockIdx.x; asm volatile("" : "+s"(b)); return b; }
namespace pg8 {
#define PG8_LAS __attribute__((address_space(3)))
typedef unsigned short bf16_t;
typedef short bf16x8 __attribute__((ext_vector_type(8)));
typedef float f32x4 __attribute__((ext_vector_type(4)));
typedef unsigned u32x4 __attribute__((ext_vector_type(4)));
constexpr int BM = 256, BK = 64, HALF = 128, HTB = HALF * BK * 2  , STAGE_BYTES = 8 * HTB, NXCD = 8, WGM = 8;

__host__ __device__ __forceinline__ int lds_byte(int r, int c) { const int st = (r >> 4) * 2 + (c >> 5), rr = r & 15, cc = c & 31, ob = rr * 64 + cc * 2; return st * 1024 + (ob ^ (((ob >> 9) & 1) << 5)); }
__host__ __device__ __forceinline__ void stage_rc(int b, int& R, int& C) { const int st = b / 1024, sb = b % 1024, swz = sb ^ (((sb >> 9) & 1) << 5); R = (st >> 1) * 16 + swz / 64; C = (st & 1) * 32 + (swz % 64) / 2; }
__host__ __device__ __forceinline__ int perm32(int rho) { const int n = rho >> 4, i = rho & 15; return 8 * (i >> 2) + 4 * n + (i & 3); }


struct Unit { int pm, pn; };
struct Gemm { const bf16_t* A; const bf16_t* Bt; int M, N, K; };
struct StaticOrder {
    int nM, nN, nwg, G, c;
    __host__ __device__ void init(int M, int N, int G_, int c_) { nM = M / BM; nN = N / BM; nwg = nM * nN; G = G_; c = c_; }
    __host__ __device__ bool next(int i, Unit& u) const {
        const long L = (long)i * G + c; if (L >= nwg) return false;
        int wgid = (int)L; { const int q = nwg / NXCD, r = nwg % NXCD, xcd = wgid % NXCD, off = wgid / NXCD; wgid = (xcd < r ? xcd * (q + 1) : r * (q + 1) + (xcd - r) * q) + off; }
        const int nig = WGM * nN, gid = wgid / nig, fm = gid * WGM, gsz = (nM - fm) < WGM ? (nM - fm) : WGM;
        u.pm = fm + ((wgid % nig) % gsz); u.pn = (wgid % nig) / gsz; return true;
    }
    __device__ __forceinline__ void a_ready(const Unit&) const {}
    __device__ __forceinline__ void done(const Unit&) const {}
};

template <class Epi, class Sched, bool STAMP = false>
__device__ __forceinline__ void gemm_phase(PG8_LAS unsigned char* lds, const Gemm g, const Sched& S, const Epi& E, unsigned long long* stamps, int wave_s) {
    const int tid = opaque_tid(wave_s), wid = __builtin_amdgcn_readfirstlane(tid >> 6), lane = tid & 63, wr = wid >> 2, wc = wid & 3, fr = lane & 15, fq = lane >> 4;
    const int K = g.K, nt = K / BK;
    int ts_lo = 0, ts_hi = 0, nts = 0; const unsigned long long rt_entry = STAMP ? (unsigned long long)wall_clock64() : 0ull;
#define PG8_STAMP() do { if (STAMP && wid == 0 && nts < 64) { const unsigned long long _c = (unsigned long long)clock64(); \
        ts_lo = (lane == nts) ? (int)(unsigned)_c : ts_lo; ts_hi = (lane == nts) ? (int)(unsigned)(_c >> 32) : ts_hi; ++nts; } } while (0)
    PG8_STAMP();
    unsigned voffA[2], voffB[2];
#pragma unroll
    for (int i = 0; i < 2; ++i) { int R, C; stage_rc(tid * 16 + i * 8192, R, C); const int Rb = Epi::PERM ? ((R & ~31) + perm32(R & 31)) : R;
        voffA[i] = (unsigned)(R * K + C) * 2u; voffB[i] = (unsigned)(Rb * K + C) * 2u; }
    const size_t kstep = (size_t)(BK * 2);
    const size_t hstep = (size_t)HALF * K * 2;
    const size_t tstep = 2 * hstep;
    const unsigned ldsw = (unsigned)wid * 1024u;
    const int aoff = lds_byte(wr * 64 + fr, fq * 8), boff = lds_byte(wc * 32 + fr, fq * 8);
#define PG8_SA(b, h) (((b) * 2 + (h)) * HTB)
#define PG8_SB(b, h) ((4 + (b) * 2 + (h)) * HTB)
#define PG8_STAGE(bufoff, gbase, voff) do { _Pragma("unroll") for (int _i = 0; _i < 2; ++_i) \
        __builtin_amdgcn_global_load_lds((const unsigned*)((const char*)(gbase) + (voff)[_i]), (PG8_LAS unsigned*)(lds + (bufoff) + ldsw + _i * 8192), 16, 0, 0); } while (0)
#define PG8_LDA(dst, b, h) do { _Pragma("unroll") for (int m = 0; m < 4; ++m) _Pragma("unroll") for (int k = 0; k < 2; ++k) dst[m][k] = *(const PG8_LAS bf16x8*)(lds + PG8_SA(b, h) + aoff + m * 2048 + k * 1024); } while (0)
#define PG8_LDB(dst, b, h) do { _Pragma("unroll") for (int n = 0; n < 2; ++n) _Pragma("unroll") for (int k = 0; k < 2; ++k) dst[n][k] = *(const PG8_LAS bf16x8*)(lds + PG8_SB(b, h) + boff + n * 2048 + k * 1024); } while (0)
#define PG8_MMA(ai, bj, At, Bt) do { __builtin_amdgcn_s_setprio(1); _Pragma("unroll") for (int k = 0; k < 2; ++k) _Pragma("unroll") for (int m = 0; m < 4; ++m) _Pragma("unroll") for (int n = 0; n < 2; ++n) \
        acc[ai][bj][m][n] = __builtin_amdgcn_mfma_f32_16x16x32_bf16(Bt[n][k], At[m][k], acc[ai][bj][m][n], 0, 0, 0); __builtin_amdgcn_s_setprio(0); } while (0)
#define PG8_MMA2(ai, b0j, b1j, At, Bt0, Bt1) do { \
        _Pragma("unroll") for (int k = 0; k < 2; ++k) _Pragma("unroll") for (int m = 0; m < 4; ++m) _Pragma("unroll") for (int n = 0; n < 2; ++n) \
            acc[ai][b0j][m][n] = __builtin_amdgcn_mfma_f32_16x16x32_bf16(Bt0[n][k], At[m][k], acc[ai][b0j][m][n], 0, 0, 0); \
        _Pragma("unroll") for (int k = 0; k < 2; ++k) _Pragma("unroll") for (int m = 0; m < 4; ++m) _Pragma("unroll") for (int n = 0; n < 2; ++n) \
            acc[ai][b1j][m][n] = __builtin_amdgcn_mfma_f32_16x16x32_bf16(Bt1[n][k], At[m][k], acc[ai][b1j][m][n], 0, 0, 0); \
        __builtin_amdgcn_s_setprio(0); } while (0)
#define PG8_WAIT_V(n) asm volatile("s_waitcnt vmcnt(" #n ")" ::: "memory")
#define PG8_WAIT_L(n) asm volatile("s_waitcnt lgkmcnt(" #n ")" ::: "memory")
#define PG8_BAR __builtin_amdgcn_s_barrier()
#define PG8_SCHED __builtin_amdgcn_sched_barrier(0)
    Unit cur, nxt; int ui = 0;
    if (!S.next(0, cur)) return;
    f32x4 acc[2][2][4][2];
#pragma unroll
    for (int a = 0; a < 2; ++a)
#pragma unroll
        for (int b = 0; b < 2; ++b)
#pragma unroll
            for (int m = 0; m < 4; ++m)
#pragma unroll
                for (int n = 0; n < 2; ++n) acc[a][b][m][n] = (f32x4){0.f, 0.f, 0.f, 0.f};
    bf16x8 At[4][2], B0[2][2], B1[2][2];
    const char* cA = (const char*)g.A + (size_t)cur.pm * tstep; const char* cB = (const char*)g.Bt + (size_t)cur.pn * tstep;
    S.a_ready(cur);
    PG8_STAGE(PG8_SB(0, 0), cB, voffB); PG8_STAGE(PG8_SA(0, 0), cA, voffA); PG8_STAGE(PG8_SB(0, 1), cB + hstep, voffB); PG8_STAGE(PG8_SA(0, 1), cA + hstep, voffA);
    PG8_STAGE(PG8_SB(1, 0), cB + kstep, voffB); PG8_STAGE(PG8_SA(1, 0), cA + kstep, voffA); PG8_STAGE(PG8_SB(1, 1), cB + hstep + kstep, voffB);
    PG8_WAIT_V(6);
    if (wr == 1) PG8_BAR;
    PG8_BAR;
    PG8_STAMP();
    for (;;) {
        const bool has_next = S.next(ui + 1, nxt);
        const char* nA = has_next ? (const char*)g.A + (size_t)nxt.pm * tstep : cA; const char* nB = has_next ? (const char*)g.Bt + (size_t)nxt.pn * tstep : cB;
        for (int t = 0; t < nt; t += 2) {
            const bool last = (t == nt - 2);
            const char* a1 = cA + (size_t)(t + 1) * kstep;
            const char* a2 = last ? nA : cA + (size_t)(t + 2) * kstep; const char* b2 = last ? nB : cB + (size_t)(t + 2) * kstep;
            const char* a3 = a2 + kstep; const char* b3 = b2 + kstep;
            if (last && has_next) S.a_ready(nxt);
            PG8_LDB(B0, 0, 0); PG8_LDA(At, 0, 0); PG8_LDB(B1, 0, 1); PG8_STAGE(PG8_SA(1, 1), a1 + hstep, voffA);
            PG8_WAIT_L(0); PG8_WAIT_V(8); __builtin_amdgcn_s_setprio(1); PG8_BAR; PG8_MMA2(0, 0, 1, At, B0, B1); PG8_BAR; PG8_SCHED;
            PG8_LDA(At, 0, 1); PG8_STAGE(PG8_SB(0, 0), b2, voffB); PG8_STAGE(PG8_SA(0, 0), a2, voffA); PG8_STAGE(PG8_SB(0, 1), b2 + hstep, voffB);
            PG8_WAIT_L(0); PG8_WAIT_V(8); __builtin_amdgcn_s_setprio(1); PG8_BAR; PG8_MMA2(1, 0, 1, At, B0, B1); PG8_BAR; PG8_SCHED;
            PG8_LDB(B0, 1, 0); PG8_LDA(At, 1, 0); PG8_LDB(B1, 1, 1); PG8_STAGE(PG8_SA(0, 1), a2 + hstep, voffA);
            PG8_WAIT_L(0); PG8_WAIT_V(8); __builtin_amdgcn_s_setprio(1); PG8_BAR; PG8_MMA2(0, 0, 1, At, B0, B1); PG8_BAR; PG8_SCHED;
            PG8_LDA(At, 1, 1); PG8_STAGE(PG8_SB(1, 0), b3, voffB); PG8_STAGE(PG8_SA(1, 0), a3, voffA); PG8_STAGE(PG8_SB(1, 1), b3 + hstep, voffB);
            PG8_WAIT_L(0); PG8_WAIT_V(8); __builtin_amdgcn_s_setprio(1); PG8_BAR; PG8_MMA2(1, 0, 1, At, B0, B1); PG8_BAR; PG8_SCHED;
        }
        PG8_STAMP();
        if constexpr (!Epi::AFTER_DRAIN) { E(acc, cur, wr, wc, fr, fq); S.done(cur); }
        PG8_STAMP();
        if (!has_next) break;
#pragma unroll
        for (int a = 0; a < 2; ++a)
#pragma unroll
            for (int b = 0; b < 2; ++b)
#pragma unroll
                for (int m = 0; m < 4; ++m)
#pragma unroll
                    for (int n = 0; n < 2; ++n) acc[a][b][m][n] = (f32x4){0.f, 0.f, 0.f, 0.f};
        cur = nxt; cA = nA; cB = nB; ++ui;
    }
    PG8_WAIT_V(0);
    if (wr == 0) PG8_BAR;
    PG8_BAR;
    if constexpr (Epi::AFTER_DRAIN) { E.fused(acc, cur, wr, wc, fr, fq, lds, wid, lane); S.done(cur); }
    PG8_STAMP();
    if (STAMP && wid == 0) { stamps[lane] = lane < nts ? (((unsigned long long)(unsigned)ts_hi << 32) | (unsigned)ts_lo) : 0ull;
        if (lane == 62) stamps[62] = rt_entry; if (lane == 63) stamps[63] = (unsigned long long)wall_clock64(); }
#undef PG8_STAMP
#undef PG8_SA
#undef PG8_SB
#undef PG8_STAGE
#undef PG8_LDA
#undef PG8_LDB
#undef PG8_MMA
#undef PG8_MMA2
#undef PG8_WAIT_V
#undef PG8_WAIT_L
#undef PG8_BAR
#undef PG8_SCHED
}

typedef __bf16 nbf2 __attribute__((ext_vector_type(2)));
typedef float f32x2n __attribute__((ext_vector_type(2)));
typedef unsigned u32x2 __attribute__((ext_vector_type(2)));
__device__ __forceinline__ unsigned pk2(float lo, float hi) { return __builtin_bit_cast(unsigned, __builtin_convertvector((f32x2n){lo, hi}, nbf2)); }
__device__ __forceinline__ u32x4 pk8(const f32x4& a, const f32x4& b) { u32x4 w; w.x = pk2(a[0], a[1]); w.y = pk2(a[2], a[3]); w.z = pk2(b[0], b[1]); w.w = pk2(b[2], b[3]); return w; }

template <int CTRL> __device__ __forceinline__ float ror16(float x) { return __builtin_bit_cast(float, __builtin_amdgcn_update_dpp(0, __builtin_bit_cast(int, x), CTRL, 0xf, 0xf, false)); }

struct EpiProj {
    static constexpr bool PERM = true, AFTER_DRAIN = false;
    bf16_t* O; int ldc; int rope_units; const float* cs; const float* sn; const float* rstd;
    __device__ __forceinline__ void operator()(const f32x4 (&acc)[2][2][4][2], const Unit& u, int wr, int wc, int fr, int fq) const {
        const int row0 = u.pm * BM + wr * 64 + fr;
        if (u.pn < rope_units) {
            const int fi = 32 * (wc & 1) + 8 * fq;
            const int colb = u.pn * BM + 128 * (wc >> 1) + fi;
#pragma unroll
            for (int ai = 0; ai < 2; ++ai)
#pragma unroll
                for (int m = 0; m < 4; ++m) {
                    const int row = row0 + ai * HALF + m * 16;
                    const f32x4 c0 = *(const f32x4*)(cs + (size_t)row * 64 + fi), c1 = *(const f32x4*)(cs + (size_t)row * 64 + fi + 4);
                    const f32x4 s0 = *(const f32x4*)(sn + (size_t)row * 64 + fi), s1 = *(const f32x4*)(sn + (size_t)row * 64 + fi + 4);
                    const float rs = rstd ? rstd[row] : 1.0f;
                    const f32x4 x1a = acc[ai][0][m][0] * rs, x1b = acc[ai][0][m][1] * rs, x2a = acc[ai][1][m][0] * rs, x2b = acc[ai][1][m][1] * rs;
                    const f32x4 la = x1a * c0 - x2a * s0, lb = x1b * c1 - x2b * s1, ha = x2a * c0 + x1a * s0, hb = x2b * c1 + x1b * s1;
                    bf16_t* rowp = O + (size_t)row * ldc + colb;
                    *(u32x4*)(rowp) = pk8(la, lb); *(u32x4*)(rowp + 64) = pk8(ha, hb);
                }
        } else {
            const int col0 = u.pn * BM + wc * 32 + 8 * fq;
#pragma unroll
            for (int ai = 0; ai < 2; ++ai)
#pragma unroll
                for (int m = 0; m < 4; ++m) { const int row = row0 + ai * HALF + m * 16; bf16_t* rowp = O + (size_t)row * ldc + col0; const float rs = rstd ? rstd[row] : 1.0f;
#pragma unroll
                    for (int bj = 0; bj < 2; ++bj) *(u32x4*)(rowp + bj * HALF) = pk8(acc[ai][bj][m][0] * rs, acc[ai][bj][m][1] * rs); }
        }
    }
};

struct EpiY {
    static constexpr bool PERM = true, AFTER_DRAIN = false;
    bf16_t* C; int ldc; float* sumsq;
    __device__ __forceinline__ void operator()(const f32x4 (&acc)[2][2][4][2], const Unit& u, int wr, int wc, int fr, int fq) const {
        const int row0 = u.pm * BM + wr * 64 + fr, col0 = u.pn * BM + wc * 32 + 8 * fq;
#pragma unroll
        for (int ai = 0; ai < 2; ++ai)
#pragma unroll
            for (int m = 0; m < 4; ++m) { const int row = row0 + ai * HALF + m * 16; bf16_t* rowp = C + (size_t)row * ldc + col0; float ss = 0.f;
#pragma unroll
                for (int bj = 0; bj < 2; ++bj) { const f32x4 v0 = acc[ai][bj][m][0], v1 = acc[ai][bj][m][1];
                    *(u32x4*)(rowp + bj * HALF) = pk8(v0, v1);
                    ss += ((v0[0] * v0[0] + v0[1] * v0[1]) + (v0[2] * v0[2] + v0[3] * v0[3])) + ((v1[0] * v1[0] + v1[1] * v1[1]) + (v1[2] * v1[2] + v1[3] * v1[3])); }
                ss += __shfl_xor(ss, 16); ss += __shfl_xor(ss, 32);
                if (fq == 0) __hip_atomic_fetch_add(sumsq + row, ss, __ATOMIC_RELAXED, __HIP_MEMORY_SCOPE_AGENT); }
    }
};

struct EpiUp {
    static constexpr bool PERM = true, AFTER_DRAIN = false;
    bf16_t* act; const float* wconv; const float* bconv; float* first; float* last; const float* rstd;
    __device__ __forceinline__ void operator()(const f32x4 (&acc)[2][2][4][2], const Unit& u, int wr, int wc, int fr, int fq) const {
        constexpr int DFF = 5632;
        const int c0 = u.pn * HALF + wc * 32 + 8 * fq;
        float rsr[2][4];
#pragma unroll
        for (int ai = 0; ai < 2; ++ai)
#pragma unroll
            for (int m = 0; m < 4; ++m) rsr[ai][m] = rstd[u.pm * BM + ai * HALF + wr * 64 + m * 16 + fr];
#pragma unroll
        for (int n = 0; n < 2; ++n) {
            const f32x4 w0 = *(const f32x4*)(wconv + c0 + 4 * n), w1 = *(const f32x4*)(wconv + DFF + c0 + 4 * n), w2 = *(const f32x4*)(wconv + 2 * DFF + c0 + 4 * n), bc = *(const f32x4*)(bconv + c0 + 4 * n);
#pragma unroll
            for (int ai = 0; ai < 2; ++ai) {
                const int seg = u.pm * 4 + ai * 2 + wr;
                f32x4 o[4];
#pragma unroll
                for (int j = 0; j < 4; ++j) {
                    float g[4], p1[4], p2[4];
#pragma unroll
                    for (int m = 0; m < 4; ++m) { g[m] = acc[ai][0][m][n][j] * rsr[ai][m]; p1[m] = ror16<0x121>(g[m]); p2[m] = ror16<0x122>(g[m]); }
#pragma unroll
                    for (int m = 0; m < 4; ++m) {
                        const float pv1 = (fr >= 1) ? p1[m] : (m > 0 ? p1[m > 0 ? m - 1 : 0] : 0.f);
                        const float pv2 = (fr >= 2) ? p2[m] : (m > 0 ? p2[m > 0 ? m - 1 : 0] : 0.f);
                        const float a = bc[j] + w2[j] * g[m] + w1[j] * pv1 + w0[j] * pv2;
                        const float sg = __builtin_amdgcn_rcpf(1.0f + __builtin_amdgcn_exp2f(-1.44269504089f * a));
                        o[m][j] = a * sg * (acc[ai][1][m][n][j] * rsr[ai][m]);
                    }
                }
#pragma unroll
                for (int m = 0; m < 4; ++m) {
                    const int row = seg * 64 + m * 16 + fr;
                    if (m > 0 || fr >= 2) { u32x2 w; w.x = pk2(o[m][0], o[m][1]); w.y = pk2(o[m][2], o[m][3]); *(u32x2*)(act + (size_t)row * DFF + c0 + 4 * n) = w; }
                }
                if (fr < 2) {
                    float* fp = first + ((size_t)(seg * 2 + fr) * 2) * DFF + c0 + 4 * n;
                    *(f32x4*)(fp) = acc[ai][0][0][n] * rsr[ai][0]; *(f32x4*)(fp + DFF) = acc[ai][1][0][n] * rsr[ai][0];
                }
                if (fr >= 14) {
                    float* lp = last + (size_t)(seg * 2 + (fr - 14)) * DFF + c0 + 4 * n;
                    *(f32x4*)(lp) = acc[ai][0][3][n] * rsr[ai][3];
                }
            }
        }
    }
};
}

using pg8::bf16_t; using pg8::bf16x8; using pg8::f32x4; using pg8::u32x4;
#define LAS PG8_LAS
typedef float f32x16 __attribute__((ext_vector_type(16)));
typedef short s16x4 __attribute__((ext_vector_type(4)));
using pg8::u32x2;

constexpr int S_ = 16384, D_ = 2048, DFF_ = 5632, NMEM_ = 256;
constexpr float EPS_ = 1e-6f;
constexpr int LDS_BYTES = pg8::STAGE_BYTES + 1024;
constexpr int NPHASE = 18;

struct Params {
    const float *x, *mem, *norms, *w_in_a, *w_o_a, *g_kv, *w_kv, *w_in_b, *w_o_b, *w_mem_kv, *w_up, *w_conv, *b_conv, *w_down;
    float* out;
    bf16_t *BtA, *BtM, *BtOA, *BtUp0, *BtDn0, *BtB, *BtOB, *BtUp1, *BtDn1;
    float *cs, *sn;
    bf16_t *h, *hm, *mkv, *big, *heads;
    float *y, *lse, *sumsq, *rstd;
    unsigned* bar;
    long long coop;
};

enum { K_PREP = 0, K_GPROJ, K_ATTN, K_MERGE, K_GY, K_ROW, K_GUP, K_FIX };
constexpr unsigned long long pack_tab(const int* a, int n, int bits) { unsigned long long v = 0; for (int i = 0; i < n; ++i) v |= (unsigned long long)a[i] << (bits * i); return v; }
constexpr int PH_KINDS[NPHASE] = {K_PREP, K_GPROJ, K_ATTN, K_MERGE, K_GY, K_ROW, K_GUP, K_FIX, K_GY, K_ROW, K_GPROJ, K_ATTN, K_GY, K_ROW, K_GUP, K_FIX, K_GY, K_ROW};
constexpr int PH_VARS[NPHASE]  = {0,      0,       0,      0,       0,    0,     0,     0,     1,    1,     2,       1,      2,    2,     1,     1,     3,    3};
constexpr int PH_SYNCS[NPHASE] = {1,      1,       1,      1,       1,    1,     1,     1,     1,    1,     1,       1,      1,    1,     1,     1,     1,    0};
constexpr unsigned long long PK_KINDS = pack_tab(PH_KINDS, NPHASE, 3), PK_VARS = pack_tab(PH_VARS, NPHASE, 2), PK_SYNCS = pack_tab(PH_SYNCS, NPHASE, 1);
__host__ __device__ inline void phase_info(int ph, int& kind, int& var, int& sync_after) {
    kind = (int)((PK_KINDS >> (3 * ph)) & 7ull); var = (int)((PK_VARS >> (2 * ph)) & 3ull); sync_after = (int)((PK_SYNCS >> ph) & 1ull);
}

__device__ __forceinline__ float wave_sum(float v) {
#pragma unroll
    for (int o = 32; o >= 1; o >>= 1) v += __shfl_xor(v, o);
    return v;
}

struct WJob { const float* W; const float* gain; bf16_t* Bt; int K, N, map; };
__device__ __forceinline__ WJob wjob(const Params& p, int j) {
    WJob w; w.gain = nullptr; w.map = 0;
    switch (j) {
    case 0: w.W = p.w_in_a; w.gain = p.norms + 0 * D_; w.Bt = p.BtA; w.K = D_; w.N = 5120; w.map = 1; break;
    case 1: w.W = p.w_mem_kv; w.gain = p.norms + 4 * D_; w.Bt = p.BtM; w.K = D_; w.N = 1024; break;
    case 2: w.W = p.w_mem_kv + (size_t)D_ * 1024; w.gain = p.norms + 9 * D_; w.Bt = p.BtM + (size_t)1024 * D_; w.K = D_; w.N = 1024; break;
    case 3: w.W = p.w_o_a; w.Bt = p.BtOA; w.K = 1024; w.N = D_; break;
    case 4: w.W = p.w_up; w.gain = p.norms + 2 * D_; w.Bt = p.BtUp0; w.K = D_; w.N = 2 * DFF_; w.map = 2; break;
    case 5: w.W = p.w_down; w.Bt = p.BtDn0; w.K = DFF_; w.N = D_; break;
    case 6: w.W = p.w_kv; w.gain = p.g_kv; w.Bt = p.BtB; w.K = D_; w.N = 3072; break;
    case 7: w.W = p.w_in_b; w.gain = p.norms + 5 * D_; w.Bt = p.BtB + (size_t)3072 * D_; w.K = D_; w.N = D_; break;
    case 8: w.W = p.w_o_b; w.Bt = p.BtOB; w.K = D_; w.N = D_; break;
    case 9: w.W = p.w_up + (size_t)D_ * 2 * DFF_; w.gain = p.norms + 7 * D_; w.Bt = p.BtUp1; w.K = D_; w.N = 2 * DFF_; w.map = 2; break;
    default: w.W = p.w_down + (size_t)DFF_ * D_; w.Bt = p.BtDn1; w.K = DFF_; w.N = D_; break;
    }
    return w;
}
__device__ __forceinline__ int dest_chunk(int map, int ci) {
    if (map == 1) { if (ci < 48) { const int u = ci >> 2, w = ci & 3; return 4 * u + 2 * (w & 1) + (w >> 1); } return ci; }
    if (map == 2) { if (ci < 88) return 4 * (ci >> 1) + (ci & 1); const int c2 = ci - 88; return 4 * (c2 >> 1) + 2 + (c2 & 1); }
    return ci;
}

constexpr unsigned MEMKV_READY_WORD = 124;
constexpr unsigned MEMKV_PIECES = 256 + 256;
__device__ __forceinline__ void prep_phase(const Params& p, LAS unsigned char* lds, int wave_s) {
    const int tid = opaque_tid(wave_s), lane = tid & 63, wid = tid >> 6;
    const int bid = opaque_bid();
    const bool memblk = bid < 8;
    unsigned* ready = p.bar + MEMKV_READY_WORD;
    if (!memblk) {
        const int nb = (int)gridDim.x - 8, bi = bid - 8;
        {
            const int r1 = NMEM_ + S_, rstep = nb * 8;
            for (int rowa = bi * 8 + wid; rowa < r1; rowa += 2 * rstep) {
                const bool two = (rowa + rstep < r1);
                int rws[2]; rws[0] = rowa; rws[1] = two ? rowa + rstep : rowa;
                f32x4 v[2][8];
#pragma unroll
                for (int r = 0; r < 2; ++r) { const float* src = rws[r] < NMEM_ ? p.mem + (size_t)rws[r] * D_ : p.x + (size_t)(rws[r] - NMEM_) * D_;
#pragma unroll
                    for (int i = 0; i < 8; ++i) v[r][i] = *(const f32x4*)(src + 4 * (lane + 64 * i)); }
#pragma unroll
                for (int r = 0; r < 2; ++r) {
                    if (r == 1 && !two) break;
                    const int vr = rws[r]; const bool ismem = vr < NMEM_;
                    bf16_t* dst = ismem ? p.hm + (size_t)vr * D_ : p.h + (size_t)(vr - NMEM_) * D_;
                    float ss = 0.f;
#pragma unroll
                    for (int i = 0; i < 8; ++i) ss += (v[r][i][0] * v[r][i][0] + v[r][i][1] * v[r][i][1]) + (v[r][i][2] * v[r][i][2] + v[r][i][3] * v[r][i][3]);
                    ss = wave_sum(ss); const float rs = 1.0f / sqrtf(ss * (1.0f / D_) + EPS_);
                    const float sc = ismem ? rs : 1.0f;
                    if (!ismem && lane == 0) p.rstd[vr - NMEM_] = rs;
#pragma unroll
                    for (int i = 0; i < 8; ++i) { u32x2 w; w.x = pg8::pk2(v[r][i][0] * sc, v[r][i][1] * sc); w.y = pg8::pk2(v[r][i][2] * sc, v[r][i][3] * sc); *(u32x2*)(dst + 4 * (lane + 64 * i)) = w; }
                    if (ismem) {
                        asm volatile("s_waitcnt vmcnt(0)" ::: "memory"); __builtin_amdgcn_fence(__ATOMIC_RELEASE, "agent"); asm volatile("s_waitcnt vmcnt(0)" ::: "memory");
                        if (lane == 0) __hip_atomic_fetch_add(ready, 1u, __ATOMIC_RELAXED, __HIP_MEMORY_SCOPE_AGENT);
                    }
                }
            }
        }
        LAS float* T = (LAS float*)lds;
        constexpr int WT[11] = {640, 0, 0, 128, 1408, 704, 384, 256, 256, 1408, 704};
        constexpr int total = 6144;
        constexpr int TP = 260;
        const int kk0 = tid >> 6, c4 = (tid & 63) * 4;
        f32x4 v[8]; float gk[8];
        WJob w; int cg = 0, kt = 0;
        auto locate = [&](int t, WJob& wj, int& cgo, int& kto) {
            int j = 0, base = 0, accum = 256;
            if (t < 256) { j = 1 + (t >> 7); base = (t >> 7) << 7; }
            else {
#pragma unroll
                for (int q = 0; q < 11; ++q) { if (t >= accum) { j = q; base = accum; } accum += WT[q]; }
            }
            wj = wjob(p, j); const int lt = t - base, ncg = wj.N / 256; cgo = lt % ncg; kto = lt / ncg;
        };
        auto issue = [&](const WJob& wj, int cgi, int kti) {
#pragma unroll
            for (int i = 0; i < 8; ++i) { const int k = kti * 64 + kk0 + 8 * i; v[i] = *(const f32x4*)(wj.W + (size_t)k * wj.N + cgi * 256 + c4); gk[i] = wj.gain ? wj.gain[k] : 1.0f; }
        };
        int t = bi;
        if (t < total) { locate(t, w, cg, kt); issue(w, cg, kt); }
        while (t < total) {
#pragma unroll
            for (int i = 0; i < 8; ++i) *(LAS f32x4*)(T + (kk0 + 8 * i) * TP + c4) = v[i] * gk[i];
            __syncthreads();
            const WJob wc = w; const int cgc = cg, ktc = kt;
            const int tn = t + nb;
            if (tn < total) { locate(tn, w, cg, kt); issue(w, cg, kt); }
            {   const int c = tid & 255, half = tid >> 8; const int drow = dest_chunk(wc.map, cgc * 4 + (c >> 6)) * 64 + (c & 63);
                bf16_t* dst = wc.Bt + (size_t)drow * wc.K + ktc * 64 + half * 32;
#pragma unroll
                for (int q = 0; q < 4; ++q) { float f[8];
#pragma unroll
                    for (int i = 0; i < 8; ++i) f[i] = T[(half * 32 + q * 8 + i) * TP + c];
                    u32x4 o; o.x = pg8::pk2(f[0], f[1]); o.y = pg8::pk2(f[2], f[3]); o.z = pg8::pk2(f[4], f[5]); o.w = pg8::pk2(f[6], f[7]);
                    *(u32x4*)(dst + q * 8) = o; }
            }
            if (t < 256) asm volatile("s_waitcnt vmcnt(0)" ::: "memory");
            __syncthreads();
            if (t < 256 && tid == 0) {
                __builtin_amdgcn_fence(__ATOMIC_RELEASE, "agent"); asm volatile("s_waitcnt vmcnt(0)" ::: "memory");
                __hip_atomic_fetch_add(ready, 1u, __ATOMIC_RELAXED, __HIP_MEMORY_SCOPE_AGENT);
            }
            t = tn;
        }
        for (int i = bi * 512 + tid; i < 4 * S_; i += nb * 512) p.sumsq[i] = 0.f;
        for (int i = bi * 512 + tid; i < S_ * 64; i += nb * 512) {
            const int pos = i >> 6, f = i & 63;
            double dinv = 1.0; for (int q = 0; q < f; ++q) dinv *= 0.8659643233600653;
            const float inv = (float)dinv;
            const float ang = (float)pos * inv;
            const double tt = (double)ang * 0.15915494309189535; const float fr = (float)(tt - rint(tt));
            p.cs[i] = __builtin_amdgcn_cosf(fr); p.sn[i] = __builtin_amdgcn_sinf(fr);
        }
    } else {
        if (tid == 0) {
            unsigned spins = 0;
            while (__hip_atomic_load(ready, __ATOMIC_RELAXED, __HIP_MEMORY_SCOPE_AGENT) < MEMKV_PIECES) { __builtin_amdgcn_s_sleep(8); if (++spins > (1u << 22)) break; }
            __builtin_amdgcn_fence(__ATOMIC_ACQUIRE, "agent"); asm volatile("s_waitcnt vmcnt(0)" ::: "memory");
        }
        __syncthreads();
        pg8::Gemm g; g.A = p.hm; g.Bt = p.BtM; g.M = NMEM_; g.N = 2048; g.K = D_;
        pg8::EpiProj E; E.cs = p.cs; E.sn = p.sn; E.O = p.mkv; E.ldc = 2048; E.rope_units = 0; E.rstd = nullptr;
        pg8::StaticOrder S; S.init(g.M, g.N, 8, bid);
        pg8::gemm_phase<pg8::EpiProj, pg8::StaticOrder, false>(lds, g, S, E, nullptr, wave_s);
    }
}

template <bool XIN32, bool OUT32>
__device__ __forceinline__ void row_phase(const bf16_t* y, const float* sumsq, const float* g, const float* xin32, bf16_t* xh, float* out32, float* rstd_out, int wave_s) {
    const int tid = opaque_tid(wave_s), lane = tid & 63, wid = tid >> 6;
    f32x4 gv[8];
#pragma unroll
    for (int i = 0; i < 8; ++i) gv[i] = *(const f32x4*)(g + 4 * (lane + 64 * i));
    const int step = (int)gridDim.x * 8;
    for (int row0 = opaque_bid() * 8 + wid; row0 < S_; row0 += 2 * step) {
        int rows[2]; rows[0] = row0; rows[1] = (row0 + step < S_) ? row0 + step : row0;
        u32x2 yw[2][8]; f32x4 xf[2][8]; u32x2 xw[2][8]; float sq[2];
#pragma unroll
        for (int r = 0; r < 2; ++r) { sq[r] = sumsq[rows[r]];
#pragma unroll
            for (int i = 0; i < 8; ++i) { const size_t o = (size_t)rows[r] * D_ + 4 * (lane + 64 * i); yw[r][i] = *(const u32x2*)(y + o);
                if (XIN32) xf[r][i] = *(const f32x4*)(xin32 + o); else xw[r][i] = *(const u32x2*)(xh + o); } }
#pragma unroll
        for (int r = 0; r < 2; ++r) {
            const int row = rows[r];
            const float ry = 1.0f / sqrtf(sq[r] * (1.0f / D_) + EPS_);
            f32x4 v[8]; float ss = 0.f;
#pragma unroll
            for (int i = 0; i < 8; ++i) {
                f32x4 yy; yy[0] = __uint_as_float(yw[r][i].x << 16); yy[1] = __uint_as_float(yw[r][i].x & 0xffff0000u); yy[2] = __uint_as_float(yw[r][i].y << 16); yy[3] = __uint_as_float(yw[r][i].y & 0xffff0000u);
                f32x4 xx;
                if (XIN32) xx = xf[r][i];
                else { xx[0] = __uint_as_float(xw[r][i].x << 16); xx[1] = __uint_as_float(xw[r][i].x & 0xffff0000u); xx[2] = __uint_as_float(xw[r][i].y << 16); xx[3] = __uint_as_float(xw[r][i].y & 0xffff0000u); }
                v[i] = xx + yy * ry * gv[i]; ss += (v[i][0] * v[i][0] + v[i][1] * v[i][1]) + (v[i][2] * v[i][2] + v[i][3] * v[i][3]); }
            if (OUT32) {
#pragma unroll
                for (int i = 0; i < 8; ++i) *(f32x4*)(out32 + (size_t)row * D_ + 4 * (lane + 64 * i)) = v[i];
            } else {
#pragma unroll
                for (int i = 0; i < 8; ++i) { u32x2 w; w.x = pg8::pk2(v[i][0], v[i][1]); w.y = pg8::pk2(v[i][2], v[i][3]); *(u32x2*)(xh + (size_t)row * D_ + 4 * (lane + 64 * i)) = w; }
                ss = wave_sum(ss); if (lane == 0) rstd_out[row] = 1.0f / sqrtf(ss * (1.0f / D_) + EPS_);
            }
        }
    }
}

__device__ __forceinline__ void fix_phase(bf16_t* act, const float* wconv, const float* bconv, const float* first, const float* last, int wave_s) {
    const int tid = opaque_tid(wave_s);
    for (int seg = opaque_bid(); seg < 256; seg += gridDim.x) {
        const float* f0 = first + (size_t)(seg * 2) * 2 * DFF_; const float* f1 = f0 + 2 * DFF_;
        const float* lp = last + (size_t)((seg > 0 ? seg - 1 : 0) * 2) * DFF_;
        f32x4 g0[3], v0[3], g1[3], v1[3], gm2[3], gm1[3], w0[3], w1[3], w2[3], bc[3];
#pragma unroll
        for (int k = 0; k < 3; ++k) { const int c = tid * 4 + 2048 * k; const int cc = c < DFF_ ? c : 0;
            g0[k] = *(const f32x4*)(f0 + cc); v0[k] = *(const f32x4*)(f0 + DFF_ + cc); g1[k] = *(const f32x4*)(f1 + cc); v1[k] = *(const f32x4*)(f1 + DFF_ + cc);
            gm2[k] = *(const f32x4*)(lp + cc); gm1[k] = *(const f32x4*)(lp + DFF_ + cc);
            w0[k] = *(const f32x4*)(wconv + cc); w1[k] = *(const f32x4*)(wconv + DFF_ + cc); w2[k] = *(const f32x4*)(wconv + 2 * DFF_ + cc); bc[k] = *(const f32x4*)(bconv + cc); }
#pragma unroll
        for (int k = 0; k < 3; ++k) { const int c = tid * 4 + 2048 * k;
            if (c < DFF_) {
                if (seg == 0) { gm2[k] = (f32x4){0.f, 0.f, 0.f, 0.f}; gm1[k] = gm2[k]; }
                const f32x4 a0 = bc[k] + w2[k] * g0[k] + w1[k] * gm1[k] + w0[k] * gm2[k], a1 = bc[k] + w2[k] * g1[k] + w1[k] * g0[k] + w0[k] * gm1[k];
                f32x4 o0, o1;
#pragma unroll
                for (int j = 0; j < 4; ++j) { o0[j] = a0[j] * __builtin_amdgcn_rcpf(1.0f + __builtin_amdgcn_exp2f(-1.44269504089f * a0[j])) * v0[k][j];
                                              o1[j] = a1[j] * __builtin_amdgcn_rcpf(1.0f + __builtin_amdgcn_exp2f(-1.44269504089f * a1[j])) * v1[k][j]; }
                u32x2 w; w.x = pg8::pk2(o0[0], o0[1]); w.y = pg8::pk2(o0[2], o0[3]); *(u32x2*)(act + (size_t)(seg * 64) * DFF_ + c) = w;
                w.x = pg8::pk2(o1[0], o1[1]); w.y = pg8::pk2(o1[2], o1[3]); *(u32x2*)(act + (size_t)(seg * 64 + 1) * DFF_ + c) = w;
            }
        }
    }
}

__device__ __forceinline__ void merge_phase(const bf16_t* og, const float* lse, bf16_t* heads, int wave_s) {
    const int tid = opaque_tid(wave_s);
    const int gs = (int)gridDim.x * 512;
    for (int i0 = opaque_bid() * 512 + tid; i0 < S_ * 64; i0 += 2 * gs) {
        int idx[2]; idx[0] = i0; idx[1] = (i0 + gs < S_ * 64) ? i0 + gs : i0;
        float l[2][3]; u32x4 a[2][3];
#pragma unroll
        for (int r = 0; r < 2; ++r) { const int pos = idx[r] >> 6, c = (idx[r] & 63) * 8, hh = c >> 7;
#pragma unroll
            for (int gq = 0; gq < 3; ++gq) { l[r][gq] = lse[(size_t)(gq * S_ + pos) * 4 + hh]; a[r][gq] = *(const u32x4*)(og + (size_t)(gq * S_ + pos) * 512 + c); } }
#pragma unroll
        for (int r = 0; r < 2; ++r) { const int pos = idx[r] >> 6, c = (idx[r] & 63) * 8;
            const float mx = fmaxf(l[r][0], fmaxf(l[r][1], l[r][2]));
            float e0 = __builtin_amdgcn_exp2f(l[r][0] - mx), e1 = __builtin_amdgcn_exp2f(l[r][1] - mx), e2 = __builtin_amdgcn_exp2f(l[r][2] - mx);
            const float inv = 1.0f / (e0 + e1 + e2); e0 *= inv; e1 *= inv; e2 *= inv;
            u32x4 w;
#pragma unroll
            for (int q = 0; q < 4; ++q) {
                const unsigned w0 = a[r][0][q], w1 = a[r][1][q], w2 = a[r][2][q];
                const float lo = __uint_as_float(w0 << 16) * e0 + __uint_as_float(w1 << 16) * e1 + __uint_as_float(w2 << 16) * e2;
                const float hi = __uint_as_float(w0 & 0xffff0000u) * e0 + __uint_as_float(w1 & 0xffff0000u) * e1 + __uint_as_float(w2 & 0xffff0000u) * e2;
                w[q] = pg8::pk2(lo, hi); }
            *(u32x4*)(heads + (size_t)pos * 1024 + c) = w; }
    }
}

struct AttnItem {
    const bf16_t* q; const bf16_t* k; const bf16_t* v; long qp, kp;
    int mode;
    int t0, t1, tstep;
    int nb0;
    bf16_t* ob; long obp; bf16_t* of; long ofp; float* ol; long olp;
};
__device__ __forceinline__ unsigned offb(unsigned row, unsigned ch) { return 256u * row + 16u * (ch ^ (((row & 3u) << 2) | ((row >> 2) & 3u))); }

__device__ __forceinline__ void attn_stage(LAS unsigned char* lds, unsigned bufoff, const bf16_t* base, long pitch, int tile, int tid, int wid) {
#pragma unroll
    for (int i = 0; i < 4; ++i) {
        const unsigned row = i * 32 + (tid >> 4), pch = tid & 15, ch = pch ^ (((row & 3u) << 2) | ((row >> 2) & 3u));
        const bf16_t* g = base + (size_t)(tile * 128 + (int)row) * pitch + ch * 8;
        __builtin_amdgcn_global_load_lds((const unsigned*)g, (LAS unsigned*)(lds + bufoff + i * 8192 + wid * 1024), 16, 0, 0);
    }
}

template <int MODE> __device__ __forceinline__ void attn_item(const AttnItem& it, LAS unsigned char* lds, int wave_s) {
    const int tid = opaque_tid(wave_s), wid = __builtin_amdgcn_readfirstlane(tid >> 6), lane = tid & 63, r = lane & 31, h = lane >> 5;
    constexpr unsigned KB0 = 0, VB0 = 65536;
    LAS unsigned* flags = (LAS unsigned*)(lds + pg8::STAGE_BYTES);
    const float sc2 = 0.08838834764831845f * 1.4426950408889634f;
    const int myblk = it.nb0 + (wid >> 2);
    const int nq = myblk * 128 + (wid & 3) * 32 + r;
    bf16x8 qf[8];
    { const bf16_t* qrow = it.q + (size_t)(wid * 32 + r) * it.qp + 8 * h;
#pragma unroll
      for (int s = 0; s < 8; ++s) qf[s] = *(const bf16x8*)(qrow + 16 * s); }
    f32x16 o[4];
#pragma unroll
    for (int d = 0; d < 4; ++d)
#pragma unroll
        for (int i = 0; i < 16; ++i) o[d][i] = 0.f;
    float mrun = -1e30f, lrun = 0.f, carry = 1.0f;
    const unsigned sw = ((r & 3u) << 2) | ((r >> 2) & 3u);
    const unsigned q4 = (lane & 15) >> 2, p4 = lane & 3, blk = (lane >> 4) & 1;
    const unsigned kbase = 256u * r + 16u * (h ^ (sw & 1u)), b3 = (sw >> 1) & 7u;
    const unsigned xv = 2u * blk + (p4 >> 1);
    const unsigned vlob = 256u * (4u * h + q4) + 16u * (xv ^ h) + 8u * (p4 & 1u), vhib = 256u * (4u * h + q4 + 8u) + 16u * (xv ^ (h + 2u)) + 8u * (p4 & 1u);

    int t = it.t0, cur = 0;
    attn_stage(lds, KB0, it.k, it.kp, t, tid, wid); attn_stage(lds, VB0, it.v, it.kp, t, tid, wid);
    asm volatile("s_waitcnt vmcnt(0)" ::: "memory"); __builtin_amdgcn_s_barrier(); asm volatile("" ::: "memory");
    for (;;) {
        const bool has_next = (t != it.t1);
        if (has_next) { attn_stage(lds, KB0 + (cur ^ 1) * 32768, it.k, it.kp, t + it.tstep, tid, wid); attn_stage(lds, VB0 + (cur ^ 1) * 32768, it.v, it.kp, t + it.tstep, tid, wid); }
        const unsigned kbuf = KB0 + cur * 32768, vbuf = VB0 + cur * 32768;
        bool relevant;
        if (MODE == 0) relevant = true; else if (MODE == 1) relevant = (t == myblk || t == myblk - 1);
        else relevant = (t <= myblk) && (__ballot(carry != 0.0f) != 0ull);
        if (relevant) {
            const bool diag = (t == myblk);
            const int iq = (wid & 3) * 32 + r, wq = wid & 3;
            auto need = [&](int kb) -> bool {
                if (MODE == 1) return (t == myblk) ? (kb <= wq) : (kb >= wq);
                if (MODE == 2) return !diag || kb <= wq;
                return true; };
            auto comp_s = [&](int kb, f32x16& sv) {
                unsigned bb = b3; asm volatile("" : "+v"(bb));
                bf16x8 kf[8];
#pragma unroll
                for (int ks = 0; ks < 8; ++ks) kf[ks] = *(const LAS bf16x8*)(lds + kbuf + kbase + 32u * ((unsigned)ks ^ bb) + kb * 8192);
                __builtin_amdgcn_sched_barrier(0);
#pragma unroll
                for (int i = 0; i < 16; ++i) sv[i] = 0.f;
#pragma unroll
                for (int ks = 0; ks < 8; ++ks) sv = __builtin_amdgcn_mfma_f32_32x32x16_bf16(kf[ks], qf[ks], sv, 0, 0, 0);
                __builtin_amdgcn_sched_barrier(0);
            };
            auto proc_pv = [&](int kb, f32x16& sv) {
                unsigned qq = q4; asm volatile("" : "+v"(qq));
                if (MODE != 2) {
                    float mx = -1e30f;
#pragma unroll
                    for (int i = 0; i < 16; ++i) {
                        float xv = sv[i] * sc2;
                        if (MODE == 1) { const int m = t * 128 + kb * 32 + (i & 3) + 8 * (i >> 2) + 4 * h; const int rel = nq - m; if (rel < 0 || rel > 128) xv = -1e30f; }
                        sv[i] = xv; mx = fmaxf(mx, xv);
                    }
                    mx = fmaxf(mx, __shfl_xor(mx, 32));
                    const float mnew = fmaxf(mrun, mx), alpha = __builtin_amdgcn_exp2f(mrun - mnew);
                    float ls = 0.f;
#pragma unroll
                    for (int i = 0; i < 16; ++i) { const float pv = (sv[i] > -1e29f) ? __builtin_amdgcn_exp2f(sv[i] - mnew) : 0.f; sv[i] = pv; ls += pv; }
                    ls += __shfl_xor(ls, 32);
                    lrun = lrun * alpha + ls; mrun = mnew;
                    if (__ballot(alpha != 1.0f) != 0ull) {
#pragma unroll
                        for (int d = 0; d < 4; ++d)
#pragma unroll
                            for (int i = 0; i < 16; ++i) o[d][i] *= alpha;
                    }
                } else {
                    float G[4], GP[4];
#pragma unroll
                    for (int i = 0; i < 16; ++i) {
                        const float e = __builtin_amdgcn_exp2f(sv[i] * sc2);
                        float kp = __builtin_amdgcn_rcpf(1.0f + e);
                        if (diag) { const int kl = kb * 32 + (i & 3) + 8 * (i >> 2) + 4 * h; if (kl >= iq) kp = 1.0f; }
                        sv[i] = kp;
                    }
#pragma unroll
                    for (int g = 0; g < 4; ++g) { G[g] = (sv[4 * g] * sv[4 * g + 1]) * (sv[4 * g + 2] * sv[4 * g + 3]); GP[g] = __shfl_xor(G[g], 32); }
                    float R = carry;
#pragma unroll
                    for (int g = 3; g >= 0; --g) {
                        float w = (h == 0) ? R * GP[g] : R;
                        R *= G[g] * GP[g];
#pragma unroll
                        for (int j = 3; j >= 0; --j) { const float kp = sv[4 * g + j]; sv[4 * g + j] = (1.0f - kp) * w; w *= kp; }
                    }
                    carry = R;
                }
#pragma unroll
                for (int s2 = 0; s2 < 2; ++s2) {
                    u32x4 pw; pw.x = pg8::pk2(sv[8 * s2 + 0], sv[8 * s2 + 1]); pw.y = pg8::pk2(sv[8 * s2 + 2], sv[8 * s2 + 3]);
                    pw.z = pg8::pk2(sv[8 * s2 + 4], sv[8 * s2 + 5]); pw.w = pg8::pk2(sv[8 * s2 + 6], sv[8 * s2 + 7]);
                    const bf16x8 pf = __builtin_bit_cast(bf16x8, pw);
                    s16x4 lo[4], hi[4];
#pragma unroll
                    for (int d = 0; d < 4; ++d) {
                        lo[d] = __builtin_amdgcn_ds_read_tr16_b64_v4i16((LAS s16x4*)(lds + vbuf + vlob + 64u * ((unsigned)d ^ qq) + kb * 8192 + s2 * 4096));
                        hi[d] = __builtin_amdgcn_ds_read_tr16_b64_v4i16((LAS s16x4*)(lds + vbuf + vhib + 64u * ((unsigned)d ^ qq) + kb * 8192 + s2 * 4096));
                    }
                    __builtin_amdgcn_sched_barrier(0);
#pragma unroll
                    for (int d = 0; d < 4; ++d) {
                        const bf16x8 vf = __builtin_shufflevector(lo[d], hi[d], 0, 1, 2, 3, 4, 5, 6, 7);
                        o[d] = __builtin_amdgcn_mfma_f32_32x32x16_bf16(vf, pf, o[d], 0, 0, 0);
                    }
                    __builtin_amdgcn_sched_barrier(0);
                }
            };
            f32x16 sa, sb;
            const bool n3 = need(3), n2 = need(2), n1 = need(1), n0 = need(0);
            auto alive = [&]() -> bool { return MODE != 2 || __ballot(carry != 0.0f) != 0ull; };
            if (n3) comp_s(3, sa);
            if (n2) comp_s(2, sb);
            if (n3) proc_pv(3, sa);
            bool al = alive();
            if (n1 && al) comp_s(1, sa);
            if (n2 && al) proc_pv(2, sb);
            al = al && alive();
            if (n0 && al) comp_s(0, sb);
            if (n1 && al) proc_pv(1, sa);
            al = al && alive();
            if (n0 && al) proc_pv(0, sb);
        }
        if (MODE == 2) { const unsigned long long bal = __ballot(carry != 0.0f); if (lane == 0) flags[(t & 1) * 8 + wid] = (bal != 0ull) ? 1u : 0u; }
        asm volatile("s_waitcnt vmcnt(0) lgkmcnt(0)" ::: "memory"); __builtin_amdgcn_s_barrier(); asm volatile("" ::: "memory");
        if (!has_next) break;
        if (MODE == 2) { unsigned any = 0;
#pragma unroll
            for (int w = 0; w < 8; ++w) any |= flags[(t & 1) * 8 + w];
            if (__builtin_amdgcn_readfirstlane(any) == 0u) break; }
        t += it.tstep; cur ^= 1;
    }
    const int qi = wid * 32 + r;
    if (MODE == 1) {
        const float inv = 1.0f / lrun;
        bf16_t* orow = it.of + (size_t)qi * it.ofp;
#pragma unroll
        for (int d = 0; d < 4; ++d)
#pragma unroll
            for (int g = 0; g < 4; ++g) { u32x2 w; w.x = pg8::pk2(o[d][4 * g] * inv, o[d][4 * g + 1] * inv); w.y = pg8::pk2(o[d][4 * g + 2] * inv, o[d][4 * g + 3] * inv);
                *(u32x2*)(orow + 32 * d + 8 * g + 4 * h) = w; }
        if (h == 0) it.ol[(size_t)qi * it.olp] = mrun + __builtin_amdgcn_logf(lrun);
    } else {
        const float inv = (MODE == 0) ? 1.0f / lrun : 1.0f;
        bf16_t* orow = it.ob + (size_t)qi * it.obp;
#pragma unroll
        for (int d = 0; d < 4; ++d)
#pragma unroll
            for (int g = 0; g < 4; ++g) { u32x2 w; w.x = pg8::pk2(o[d][4 * g] * inv, o[d][4 * g + 1] * inv); w.y = pg8::pk2(o[d][4 * g + 2] * inv, o[d][4 * g + 3] * inv);
                *(u32x2*)(orow + 32 * d + 8 * g + 4 * h) = w; }
    }
}

__device__ __forceinline__ void attn_phase(const Params& p, int layer, LAS unsigned char* lds, int wave_s) {
    const int nitems = 768 + 256;
    for (int item = opaque_bid(); item < nitems; item += gridDim.x) {
        AttnItem it;
        it.ob = nullptr; it.obp = 0; it.of = nullptr; it.ofp = 0; it.ol = nullptr; it.olp = 0; it.tstep = 1; it.nb0 = 0;
        if (item >= 768) {
            const int mi = item - 768, hm = mi & 3, qb = mi >> 2;
            it.mode = 0; it.t0 = 0; it.t1 = 1;
            it.q = p.big + (size_t)(qb * 256) * 5120 + 4608 + hm * 128; it.qp = 5120;
            it.k = p.mkv + layer * 1024 + hm * 128; it.v = it.k + 512; it.kp = 2048;
            if (layer == 0) { it.ob = p.heads + (size_t)(qb * 256) * 1024 + 512 + hm * 128; it.obp = 1024; }
            else { it.ob = p.heads + (size_t)(qb * 256) * 2048 + 1536 + hm * 128; it.obp = 2048; }
        } else if (layer == 0) {
            const int g = item >> 8, li = item & 255, hh = li & 3, rest = li >> 2;
            const int dl = (g == 0) ? 1 : (g == 1 ? 4 : 16), npair = 64 / dl, rs = rest / npair, pr = rest % npair;
            const int hd = g * 4 + hh;
            it.mode = 1; it.nb0 = 2 * pr; it.t0 = (pr == 0) ? 0 : 2 * pr - 1; it.t1 = 2 * pr + 1;
            const size_t prow = (size_t)(pr * 256) * dl + rs;
            it.q = p.big + prow * 5120 + hd * 128; it.qp = (long)dl * 5120;
            it.k = p.big + (size_t)rs * 5120 + 1536 + hd * 128; it.v = it.k + 1536; it.kp = (long)dl * 5120;
            it.of = (bf16_t*)p.y + (size_t)g * S_ * 512 + prow * 512 + hh * 128; it.ofp = (long)dl * 512;
            it.ol = p.lse + (size_t)g * S_ * 4 + prow * 4 + hh; it.olp = (long)dl * 4;
        } else {
            const int hd = item % 12, qb = item / 12;
            it.mode = 2; it.nb0 = 2 * qb; it.t0 = 2 * qb + 1; it.t1 = 0; it.tstep = -1;
            it.q = p.big + (size_t)(qb * 256) * 5120 + 3072 + hd * 128; it.qp = 5120;
            it.k = p.big + hd * 128; it.v = it.k + 1536; it.kp = 5120;
            it.ob = p.heads + (size_t)(qb * 256) * 2048 + hd * 128; it.obp = 2048;
        }
        if (it.mode == 0) attn_item<0>(it, lds, wave_s); else if (it.mode == 1) attn_item<1>(it, lds, wave_s); else attn_item<2>(it, lds, wave_s);
    }
}

#define XB_TMO      128
#define XB_XCNT(j)  (256  + 64 * (j))
#define XB_XSUB(j)  (1280 + 64 * (j))
#define XB_XGEN(j)  (2304 + 64 * (j))
#define XB_TOP      3328
#define XB_TOPGEN   3392
#define XCD_BAR_WORDS 3456
#define XB_SPIN_CAP (1u << 18)

__device__ __forceinline__ unsigned xb_ld(unsigned* p)              { return __hip_atomic_load(p, __ATOMIC_RELAXED, __HIP_MEMORY_SCOPE_AGENT); }
__device__ __forceinline__ unsigned xb_add(unsigned* p, unsigned v) { return __hip_atomic_fetch_add(p, v, __ATOMIC_RELAXED, __HIP_MEMORY_SCOPE_AGENT); }
__device__ __forceinline__ unsigned xb_xcc_id() { return (unsigned)__builtin_amdgcn_s_getreg((3 << 11) | 20) & 0xFu; }
#define XB_SPIN(cond, bar) do { unsigned _sp = 0; while (cond) { __builtin_amdgcn_s_sleep(1); \
    if ((++_sp & 255u) == 0u) { if (xb_ld(&(bar)[XB_TMO])) break; if (_sp > XB_SPIN_CAP) { atomicAdd(&(bar)[XB_TMO], 1u); break; } } } } while (0)

struct XcdBarrier {
    unsigned* bar; unsigned x;
    volatile LAS unsigned* st;
};

__device__ __forceinline__ XcdBarrier xcd_barrier_post(unsigned* bar, volatile LAS unsigned* st, int tid) {
    XcdBarrier b; b.bar = bar; b.x = xb_xcc_id(); b.st = st;
    if (tid == 0) (void)xb_add(&bar[XB_XCNT(b.x)], 1u);
    return b;
}
__device__ __forceinline__ void xcd_barrier_complete(unsigned* bar, unsigned x, unsigned& nloc, unsigned& nx) {
    const unsigned G = gridDim.x * gridDim.y * gridDim.z;
    unsigned sum, cnt, mine, sp = 0u;
    for (;;) {
        sum = 0u; cnt = 0u; mine = 0u;
#pragma unroll
        for (unsigned j = 0; j < 16; ++j) { const unsigned c = xb_ld(&bar[XB_XCNT(j)]); sum += c; cnt += (c > 0u) ? 1u : 0u; mine = (j == x) ? c : mine; }
        if (sum == G) break;
        __builtin_amdgcn_s_sleep(1);
        if ((++sp & 255u) == 0u) { if (xb_ld(&bar[XB_TMO])) break; if (sp > XB_SPIN_CAP) { atomicAdd(&bar[XB_TMO], 1u); break; } }
    }
    nloc = mine > 0u ? mine : 1u; nx = cnt > 0u ? cnt : 1u;
}

__device__ __forceinline__ void xcd_barrier(const XcdBarrier& b, int tid) {
    asm volatile("s_waitcnt vmcnt(0)" ::: "memory");
    __syncthreads();
    if (tid == 0) {
        unsigned* bar = b.bar;
        __builtin_amdgcn_s_waitcnt(0);
        unsigned nloc = b.st[0], nx = b.st[1];
        if (nloc == 0u) { xcd_barrier_complete(bar, b.x, nloc, nx); b.st[0] = nloc; b.st[1] = nx; }
        const unsigned old = xb_add(&bar[XB_XSUB(b.x)], 1u);
        const unsigned gen = old / nloc;
        if (old + 1u == (gen + 1u) * nloc) {
            __builtin_amdgcn_fence(__ATOMIC_RELEASE, "agent");
            asm volatile("s_waitcnt vmcnt(0)" ::: "memory");
            const unsigned og = xb_add(&bar[XB_TOP], 1u);
            const unsigned tg = og / nx;
            if (og + 1u == (tg + 1u) * nx) xb_add(&bar[XB_TOPGEN], 1u);
            else XB_SPIN(xb_ld(&bar[XB_TOPGEN]) == tg, bar);
            __builtin_amdgcn_fence(__ATOMIC_ACQUIRE, "agent");
            xb_add(&bar[XB_XGEN(b.x)], 1u);
            asm volatile("s_waitcnt vmcnt(0)" ::: "memory");
        } else {
            XB_SPIN(xb_ld(&bar[XB_XGEN(b.x)]) == gen, bar);
            __builtin_amdgcn_fence(__ATOMIC_ACQUIRE, "agent");
            asm volatile("s_waitcnt vmcnt(0)" ::: "memory");
        }
    }
    __syncthreads();
}

__global__ __launch_bounds__(512, 2) void yoco_forward(Params p, int ph0, int ph1) {
    extern __shared__ __attribute__((aligned(16))) unsigned char shm[];
    LAS unsigned char* lds = (LAS unsigned char*)shm;
    const int wave_s = __builtin_amdgcn_readfirstlane((int)(threadIdx.x >> 6));
    volatile LAS unsigned* xbst = (volatile LAS unsigned*)(lds + pg8::STAGE_BYTES + 256);
    XcdBarrier xb; xb.bar = p.bar; xb.x = 0; xb.st = xbst;
    if (p.coop == 1) {
        const int t0 = opaque_tid(wave_s);
        if (t0 == 0) { xbst[0] = 0u; xbst[1] = 0u; xbst[2] = 0u; xbst[3] = 0u; }
        __syncthreads();
        xb = xcd_barrier_post(p.bar, xbst, t0);
        if (t0 == 0) xbst[2] = xb_add(&p.bar[8u * xb.x], 1u);
    }
    int unit_c = (int)blockIdx.x;
    for (int ph = ph0; ph < ph1; ++ph) {
        int kind, var, sync_after; phase_info(ph, kind, var, sync_after);
#ifndef ONLY_KIND
#define EN(k) true
#else
#define EN(k) ((k) == ONLY_KIND)
#endif
        if (kind == K_PREP && EN(K_PREP)) {
            prep_phase(p, lds, wave_s);
        } else if (kind == K_GPROJ && EN(K_GPROJ)) {
            pg8::Gemm g; pg8::EpiProj E; E.cs = p.cs; E.sn = p.sn;
            E.rstd = p.rstd; g.A = p.h; g.M = S_; g.N = 5120; g.K = D_; E.O = p.big; E.ldc = 5120;
            if (var == 0) { g.Bt = p.BtA; E.rope_units = 12; } else { g.Bt = p.BtB; E.rope_units = 0; }
            pg8::StaticOrder S; S.init(g.M, g.N, (int)gridDim.x, unit_c);
            pg8::gemm_phase<pg8::EpiProj, pg8::StaticOrder, false>(lds, g, S, E, nullptr, wave_s);
        } else if (kind == K_ATTN && EN(K_ATTN)) {
            attn_phase(p, var, lds, wave_s);
        } else if (kind == K_MERGE && EN(K_MERGE)) {
            merge_phase((const bf16_t*)p.y, p.lse, p.heads, wave_s);
        } else if (kind == K_GY && EN(K_GY)) {
            pg8::Gemm g; pg8::EpiY E; E.C = (bf16_t*)p.y; E.ldc = D_; E.sumsq = p.sumsq + var * S_; g.M = S_; g.N = D_;
            if (var == 0) { g.A = p.heads; g.Bt = p.BtOA; g.K = 1024; }
            else if (var == 1) { g.A = p.big; g.Bt = p.BtDn0; g.K = DFF_; }
            else if (var == 2) { g.A = p.heads; g.Bt = p.BtOB; g.K = D_; }
            else { g.A = p.big; g.Bt = p.BtDn1; g.K = DFF_; }
            pg8::StaticOrder S; S.init(g.M, g.N, (int)gridDim.x, unit_c);
            pg8::gemm_phase<pg8::EpiY, pg8::StaticOrder, false>(lds, g, S, E, nullptr, wave_s);
        } else if (kind == K_ROW && EN(K_ROW)) {
            const int layer = var >> 1, which = var & 1;
            const float* gn = p.norms + (size_t)(layer * 5 + (which ? 3 : 1)) * D_;
            if (var == 0) row_phase<true, false>((const bf16_t*)p.y, p.sumsq, gn, p.x, p.h, nullptr, p.rstd, wave_s);
            else if (var == 3) row_phase<false, true>((const bf16_t*)p.y, p.sumsq + 3 * S_, gn, nullptr, p.h, p.out, p.rstd, wave_s);
            else row_phase<false, false>((const bf16_t*)p.y, p.sumsq + var * S_, gn, nullptr, p.h, nullptr, p.rstd, wave_s);
        } else if (kind == K_GUP && EN(K_GUP)) {
            pg8::Gemm g; g.A = p.h; g.Bt = var ? p.BtUp1 : p.BtUp0; g.M = S_; g.N = 2 * DFF_; g.K = D_;
            pg8::EpiUp E; E.act = p.big; E.wconv = p.w_conv + (size_t)var * 3 * DFF_; E.bconv = p.b_conv + (size_t)var * DFF_; E.first = p.y; E.last = p.y + (size_t)256 * 4 * DFF_; E.rstd = p.rstd;
            pg8::StaticOrder S; S.init(g.M, g.N, (int)gridDim.x, unit_c);
            pg8::gemm_phase<pg8::EpiUp, pg8::StaticOrder, false>(lds, g, S, E, nullptr, wave_s);
        } else if (EN(K_FIX)) {
            fix_phase(p.big, p.w_conv + (size_t)var * 3 * DFF_, p.b_conv + (size_t)var * DFF_, p.y, p.y + (size_t)256 * 4 * DFF_, wave_s);
        }
        if (sync_after && ph + 1 < ph1) {
            if (p.coop == 1) xcd_barrier(xb, opaque_tid(wave_s));
            if (p.coop == 1 && ph == 0) {
                bool ok = (gridDim.x % 8u) == 0u;
                for (unsigned j = 0; j < 16; ++j) { const unsigned cnt = xb_ld(&p.bar[8u * j]); ok = ok && (cnt == (j < 8u ? gridDim.x / 8u : 0u)); }
                if (ok) unit_c = (int)(xbst[2] * 8u + xb.x);
            }
            else if (p.coop == 2) cooperative_groups::this_grid().sync();
        }
    }
}

#ifndef MK_LAUNCHES
#define MK_LAUNCHES 0
#endif

extern "C" void kernel_launch(void* const* d_in, const int* in_sizes, int n_in, void* d_out, int out_size, void* d_ws, size_t ws_size, hipStream_t stream) {
    (void)in_sizes; (void)n_in; (void)out_size;
    Params p{};
    p.x = (const float*)d_in[0]; p.mem = (const float*)d_in[1]; p.norms = (const float*)d_in[2]; p.w_in_a = (const float*)d_in[3]; p.w_o_a = (const float*)d_in[4];
    p.g_kv = (const float*)d_in[5]; p.w_kv = (const float*)d_in[6]; p.w_in_b = (const float*)d_in[7]; p.w_o_b = (const float*)d_in[8]; p.w_mem_kv = (const float*)d_in[9];
    p.w_up = (const float*)d_in[10]; p.w_conv = (const float*)d_in[11]; p.b_conv = (const float*)d_in[12]; p.w_down = (const float*)d_in[13];
    p.out = (float*)d_out;
    unsigned char* w = (unsigned char*)d_ws; size_t off = 0;
    auto take = [&](size_t bytes) { unsigned char* r = w + off; off += (bytes + 255) & ~(size_t)255; return r; };
    p.BtA = (bf16_t*)take((size_t)5120 * D_ * 2); p.BtM = (bf16_t*)take((size_t)2048 * D_ * 2); p.BtOA = (bf16_t*)take((size_t)D_ * 1024 * 2);
    p.BtUp0 = (bf16_t*)take((size_t)2 * DFF_ * D_ * 2); p.BtDn0 = (bf16_t*)take((size_t)D_ * DFF_ * 2); p.BtB = (bf16_t*)take((size_t)5120 * D_ * 2);
    p.BtOB = (bf16_t*)take((size_t)D_ * D_ * 2); p.BtUp1 = (bf16_t*)take((size_t)2 * DFF_ * D_ * 2); p.BtDn1 = (bf16_t*)take((size_t)D_ * DFF_ * 2);
    p.cs = (float*)take((size_t)S_ * 64 * 4); p.sn = (float*)take((size_t)S_ * 64 * 4);
    p.h = (bf16_t*)take((size_t)S_ * D_ * 2); p.hm = (bf16_t*)take((size_t)NMEM_ * D_ * 2); p.mkv = (bf16_t*)take((size_t)NMEM_ * 2048 * 2);
    p.big = (bf16_t*)take((size_t)S_ * DFF_ * 2); p.heads = (bf16_t*)take((size_t)S_ * D_ * 2);
    p.y = (float*)take((size_t)S_ * D_ * 4); p.lse = (float*)take((size_t)3 * S_ * 4 * 4); p.sumsq = (float*)take((size_t)4 * S_ * 4);
    p.rstd = (float*)take((size_t)S_ * 4);
    p.bar = (unsigned*)take((size_t)XCD_BAR_WORDS * 4);
    if (off > ws_size) { fprintf(stderr, "workspace too small: need %zu have %zu\n", off, ws_size); return; }
    static int grid_blocks = 0;
    if (!grid_blocks) {
        int dev = 0, cus = 0, per_cu = 0;
        hipGetDevice(&dev); hipDeviceGetAttribute(&cus, hipDeviceAttributeMultiprocessorCount, dev);
        hipFuncSetAttribute((const void*)yoco_forward, hipFuncAttributeMaxDynamicSharedMemorySize, LDS_BYTES);
        hipOccupancyMaxActiveBlocksPerMultiprocessor(&per_cu, yoco_forward, 512, LDS_BYTES);
        if (per_cu < 1) per_cu = 1;
        grid_blocks = cus * per_cu;
    }
    hipMemsetAsync(p.bar, 0, (size_t)XCD_BAR_WORDS * 4, stream);
#if MK_LAUNCHES
    p.coop = 0;
    int ph = 0;
    while (ph < NPHASE) {
        int e = ph; for (;;) { int kind, var, sy; phase_info(e, kind, var, sy); ++e; if (sy || e >= NPHASE) break; }
        hipLaunchKernelGGL(yoco_forward, dim3(grid_blocks), dim3(512), LDS_BYTES, stream, p, ph, e);
        ph = e;
    }
#else
    p.coop = 1;
    int ph0 = 0, ph1 = NPHASE;
    void* args[] = {&p, &ph0, &ph1};
    hipError_t e = hipLaunchCooperativeKernel((const void*)yoco_forward, dim3(grid_blocks), dim3(512), args, LDS_BYTES, stream);
    if (e != hipSuccess) fprintf(stderr, "cooperative launch failed: %s (grid %d)\n", hipGetErrorString(e), grid_blocks);
#endif
}
```
